# Optimizing an MI355X kernel written in HIP

```python
import math
import jax
import jax.numpy as jnp
from jax import lax
import numpy as np

D_MODEL = 1024
BATCH = 16
SEQ = 2048
DEPTH = 1

GRID_W = 64
CTX_LEN = 256
N_MOD = 9
D_FF = 2816
RMS_EPS = 1e-6

RWKV_HEADS = 8
RWKV_HEAD_DIM = 64
RWKV_WIDTH = RWKV_HEADS * RWKV_HEAD_DIM
DECAY_LORA = 64
AAA_LORA = 64
GATE_LORA = 128
RWKV_COLS = 3 * RWKV_WIDTH + 2 * DECAY_LORA + 2 * AAA_LORA + GATE_LORA
RWKV_SPLITS = [RWKV_WIDTH, 2 * RWKV_WIDTH, 3 * RWKV_WIDTH,
               3 * RWKV_WIDTH + 2 * DECAY_LORA,
               3 * RWKV_WIDTH + 2 * DECAY_LORA + 2 * AAA_LORA]
RWKV_GN_EPS = 64e-5
SHIFT_TAPS = 3

DIFF_HEADS = 4
DIFF_HEAD_DIM = 64
DIFF_V_DIM = 2 * DIFF_HEAD_DIM
DIFF_WIDTH = DIFF_HEADS * DIFF_V_DIM
DIFF_COLS = 3 * DIFF_WIDTH
Q_BLOCK = 128
ROPE_BASE = 10000.0
ROPE_FREQS = DIFF_HEAD_DIM // 4

N_BRANCH = 2
MIX_COLS = RWKV_COLS + DIFF_COLS + N_BRANCH * D_MODEL

kernel_name = "hybrid_rwkv7_diffattn_macaron_dit_layer"


def _rms(x, g):
    xf = x.astype(jnp.float32)
    y = xf * lax.rsqrt(jnp.mean(xf * xf, axis=-1, keepdims=True) + RMS_EPS)
    return (y * g).astype(x.dtype)


def _modulate(h, shift, scale):
    return h * (1.0 + scale) + shift


def _adaln(cond, w, b):
    m = jax.nn.silu(cond) @ w + b
    return m.reshape(m.shape[:-1] + (N_MOD, D_MODEL))


def _swiglu(h, w_in, w_out):
    gate, up = jnp.split(h @ w_in, 2, axis=-1)
    return (jax.nn.silu(gate) * up) @ w_out


def _ffn_half_step(x, m, pre_g, post_g, w_in, w_out):
    h = _modulate(_rms(x, pre_g), m[..., 0, :], m[..., 1, :])
    return x + 0.5 * m[..., 2, :] * _rms(_swiglu(h, w_in, w_out), post_g)


def _short_conv(u, w):
    up = jnp.pad(u, ((0, 0), (1, 1), (0, 0)))
    return up[:, :-2] * w[0] + up[:, 1:-1] * w[1] + up[:, 2:] * w[2]


def _axial_angles(rows):
    row = jnp.repeat(jnp.arange(rows, dtype=jnp.float32), GRID_W)
    col = jnp.tile(jnp.arange(GRID_W, dtype=jnp.float32), rows)
    freqs = ROPE_BASE ** (-jnp.arange(ROPE_FREQS, dtype=jnp.float32) / ROPE_FREQS)
    return row[:, None] * freqs, col[:, None] * freqs


def _rotate(z, ang):
    c = jnp.cos(ang)[None, :, None, None, :]
    s = jnp.sin(ang)[None, :, None, None, :]
    z1, z2 = jnp.split(z, 2, axis=-1)
    return jnp.concatenate([z1 * c - z2 * s, z2 * c + z1 * s], axis=-1)


def _rope_2d(z, ang_row, ang_col):
    zr, zc = jnp.split(z, 2, axis=-1)
    return jnp.concatenate([_rotate(zr, ang_row), _rotate(zc, ang_col)], axis=-1).astype(z.dtype)


def _rwkv_streams(u, shift_w, w0, w2, a0, a2, g2, k_k, k_a):
    u = _short_conv(u, shift_w)
    B, T, _ = u.shape
    r, k, v, wd, ad, gd = jnp.split(u, RWKV_SPLITS, axis=-1)
    wd = wd.reshape(B, T, 2, DECAY_LORA)
    ad = ad.reshape(B, T, 2, AAA_LORA)
    w_logit = (w0 + jnp.einsum("btdr,drc->btdc", jnp.tanh(wd), w2)).astype(jnp.float32)
    decay = jnp.exp(-jnp.exp(-jax.nn.softplus(-w_logit) - 0.5))
    a = jax.nn.sigmoid(a0 + jnp.einsum("btdr,drc->btdc", ad, a2))
    g = jax.nn.sigmoid(gd) @ g2
    kk = (k * k_k).astype(jnp.float32).reshape(B, T, RWKV_HEADS, RWKV_HEAD_DIM)
    kk = kk * lax.rsqrt(jnp.sum(kk * kk, axis=-1, keepdims=True) + 1e-12)
    k_dir = k[:, :, None, :] * (1.0 + (a - 1.0) * k_a)
    heads = lambda t: t.reshape(t.shape[:-1] + (RWKV_HEADS, RWKV_HEAD_DIM))
    return heads(r), heads(v), kk, heads(k_dir), heads(decay), heads(a), g


def _rwkv7_scan(s0, r, w, k, v, kk, a, reverse, collect):
    xs = tuple(jnp.moveaxis(t.astype(jnp.float32), 1, 0) for t in (r, w, k, v, kk, a))

    def step(s, inp):
        r_t, w_t, k_t, v_t, kk_t, a_t = inp
        sa = jnp.einsum("bhvk,bhk->bhv", s, kk_t)
        s = (s * w_t[:, :, None, :] - sa[..., None] * (kk_t * a_t)[:, :, None, :]
             + v_t[..., None] * k_t[:, :, None, :])
        y = jnp.einsum("bhvk,bhk->bhv", s, r_t) if collect else None
        return s, y

    s_fin, ys = lax.scan(step, s0, xs, reverse=reverse)
    return s_fin, (jnp.moveaxis(ys, 0, 1) if collect else None)


def _rwkv_readout(y, r, v, k_dir, g, r_k, ln_g, ln_b):
    B, T = y.shape[:2]
    mu = jnp.mean(y, axis=-1, keepdims=True)
    var = jnp.mean(jnp.square(y - mu), axis=-1, keepdims=True)
    yn = ((y - mu) * lax.rsqrt(var + RWKV_GN_EPS)).reshape(B, T, RWKV_WIDTH) * ln_g + ln_b
    bonus = jnp.sum(r[:, :, None] * k_dir * r_k, axis=(2, 4))[..., None] * v
    return ((yn + bonus.reshape(B, T, RWKV_WIDTH)) * g).astype(g.dtype)


def _rwkv_bidir(streams, s0, collect, r_k, ln_g, ln_b):
    r, v, kk, k_dir, decay, a, g = streams
    finals, ys = [], []
    for d, rev in enumerate((False, True)):
        s_fin, y = _rwkv7_scan(s0[d], r, decay[:, :, d], k_dir[:, :, d], v, kk, a[:, :, d], rev, collect)
        finals.append(s_fin)
        ys.append(y)
    if not collect:
        return finals, None
    return finals, _rwkv_readout(ys[0] + ys[1], r, v, k_dir, g, r_k, ln_g, ln_b)


def _diff_split(u):
    B, T, _ = u.shape
    q, k, v = jnp.split(u, 3, axis=-1)
    return (q.reshape(B, T, DIFF_HEADS, 2, DIFF_HEAD_DIM),
            k.reshape(B, T, DIFF_HEADS, 2, DIFF_HEAD_DIM),
            v.reshape(B, T, DIFF_HEADS, DIFF_V_DIM))


def _diff_attend(q, k, v, lam):
    s = jnp.einsum("bqhcd,bkhcd->bhcqk", q, k).astype(jnp.float32) * DIFF_HEAD_DIM ** -0.5
    p = jax.nn.softmax(s, axis=-1)
    attn = (p[:, :, 0] - lam * p[:, :, 1]).astype(v.dtype)
    return jnp.einsum("bhqk,bkhe->bqhe", attn, v)


def _diff_out(o, subln_g, lam_init):
    B, T = o.shape[:2]
    return (_rms(o, subln_g) * (1.0 - lam_init)).reshape(B, T, DIFF_WIDTH)


def _gated_merge(ya, yb, gate_cols, up_a, up_b, w_out):
    ga, gb = jnp.split(jax.nn.sigmoid(gate_cols), N_BRANCH, axis=-1)
    return (ga * (ya @ up_a) + gb * (yb @ up_b)) @ w_out


def setup_inputs(seed: int = 0) -> dict:
    key = jax.random.key(seed)
    ks = iter(jax.random.split(key, 32))
    f32 = jnp.float32
    L, D = DEPTH, D_MODEL

    def nrm(shape, s):
        return jax.random.normal(next(ks), shape, f32) * s

    side = jax.random.uniform(next(ks), (L, 2, RWKV_COLS), f32, 0.0, 0.5)
    shift_w = jnp.stack([side[:, 0], 1.0 - 0.5 * (side[:, 0] + side[:, 1]), side[:, 1]], axis=1)
    return {
        "x": nrm((BATCH, SEQ, D), 1.0),
        "c": nrm((BATCH, D), 1.0),
        "ctx": nrm((BATCH, CTX_LEN, D), 1.0),
        "c_ctx": nrm((D,), 1.0),
        "ada_w": nrm((L, D, N_MOD * D), 0.5 * D ** -0.5),
        "ada_b": nrm((L, N_MOD * D), 0.02),
        "pre_norm_g": 1.0 + nrm((L, 3, D), 0.1),
        "post_norm_g": 1.0 + nrm((L, 3, D), 0.1),
        "ffn1_w_in": nrm((L, D, 2 * D_FF), D ** -0.5),
        "ffn1_w_out": nrm((L, D_FF, D), D_FF ** -0.5),
        "mix_w_in": nrm((L, D, MIX_COLS), D ** -0.5),
        "rwkv_shift_w": shift_w,
        "rwkv_w0": jax.random.uniform(next(ks), (L, 2, RWKV_WIDTH), f32, -6.0, 1.0),
        "rwkv_w2": nrm((L, 2, DECAY_LORA, RWKV_WIDTH), 0.5 * DECAY_LORA ** -0.5),
        "rwkv_a0": nrm((L, 2, RWKV_WIDTH), 0.3),
        "rwkv_a2": nrm((L, 2, AAA_LORA, RWKV_WIDTH), 0.5 * AAA_LORA ** -0.5),
        "rwkv_g2": nrm((L, GATE_LORA, RWKV_WIDTH), GATE_LORA ** -0.5),
        "rwkv_k_k": 0.85 + nrm((L, RWKV_WIDTH), 0.05),
        "rwkv_k_a": 1.0 + nrm((L, RWKV_WIDTH), 0.05),
        "rwkv_r_k": nrm((L, RWKV_HEADS, RWKV_HEAD_DIM), 0.1),
        "rwkv_ln_g": 1.0 + nrm((L, RWKV_WIDTH), 0.1),
        "rwkv_ln_b": nrm((L, RWKV_WIDTH), 0.02),
        "diff_lambda": nrm((L, 4, DIFF_HEAD_DIM), 0.1),
        "diff_subln_g": 1.0 + nrm((L, DIFF_V_DIM), 0.1),
        "branch_up_a": nrm((L, RWKV_WIDTH, D), RWKV_WIDTH ** -0.5),
        "branch_up_b": nrm((L, DIFF_WIDTH, D), DIFF_WIDTH ** -0.5),
        "mix_w_out": nrm((L, D, D), D ** -0.5),
        "ffn2_w_in": nrm((L, D, 2 * D_FF), D ** -0.5),
        "ffn2_w_out": nrm((L, D_FF, D), D_FF ** -0.5),
    }


def reference(x, c, ctx, c_ctx, ada_w, ada_b, pre_norm_g, post_norm_g,
              ffn1_w_in, ffn1_w_out, mix_w_in, rwkv_shift_w, rwkv_w0, rwkv_w2,
              rwkv_a0, rwkv_a2, rwkv_g2, rwkv_k_k, rwkv_k_a, rwkv_r_k,
              rwkv_ln_g, rwkv_ln_b, diff_lambda, diff_subln_g,
              branch_up_a, branch_up_b, mix_w_out, ffn2_w_in, ffn2_w_out):
    B, T, _ = x.shape
    rows = T // GRID_W
    ang_row, ang_col = _axial_angles(rows)
    zero_state = jnp.zeros((B, RWKV_HEADS, RWKV_HEAD_DIM, RWKV_HEAD_DIM), jnp.float32)
    split_cols = [RWKV_COLS, RWKV_COLS + DIFF_COLS]
    n_blk = T // Q_BLOCK

    for l in range(DEPTH):
        last = l == DEPTH - 1
        lam_init = 0.8 - 0.6 * math.exp(-0.3 * l)
        m_x = _adaln(c, ada_w[l], ada_b[l])[:, None]
        m_c = _adaln(c_ctx, ada_w[l], ada_b[l])[None, None]

        x = _ffn_half_step(x, m_x[..., 0:3, :], pre_norm_g[l, 0], post_norm_g[l, 0],
                           ffn1_w_in[l], ffn1_w_out[l])
        ctx = _ffn_half_step(ctx, m_c[..., 0:3, :], pre_norm_g[l, 0], post_norm_g[l, 0],
                             ffn1_w_in[l], ffn1_w_out[l])

        hx = _modulate(_rms(x, pre_norm_g[l, 1]), m_x[..., 3, :], m_x[..., 4, :])
        hc = _modulate(_rms(ctx, pre_norm_g[l, 1]), m_c[..., 3, :], m_c[..., 4, :])
        rx, dx, gx = jnp.split(hx @ mix_w_in[l], split_cols, axis=-1)
        rc, dc, gc = jnp.split(hc @ mix_w_in[l], split_cols, axis=-1)

        rwkv_p = (rwkv_shift_w[l], rwkv_w0[l], rwkv_w2[l], rwkv_a0[l], rwkv_a2[l],
                  rwkv_g2[l], rwkv_k_k[l], rwkv_k_a[l])
        read_p = (rwkv_r_k[l], rwkv_ln_g[l], rwkv_ln_b[l])
        st_c = _rwkv_streams(rc, *rwkv_p)
        st_x = _rwkv_streams(rx, *rwkv_p)
        ctx_states, ya_c = _rwkv_bidir(st_c, (zero_state, zero_state), not last, *read_p)
        _, ya_x = _rwkv_bidir(st_x, ctx_states, True, *read_p)

        lq1, lk1, lq2, lk2 = diff_lambda[l].astype(jnp.float32)
        lam = jnp.exp(jnp.sum(lq1 * lk1)) - jnp.exp(jnp.sum(lq2 * lk2)) + lam_init
        qc, kc, vc = _diff_split(dc)
        qx, kx, vx = _diff_split(dx)
        qx = _rope_2d(qx, ang_row, ang_col)
        kx = _rope_2d(kx, ang_row, ang_col)
        k_all = jnp.concatenate([kc, kx], axis=1)
        v_all = jnp.concatenate([vc, vx], axis=1)
        q_blk = jnp.moveaxis(qx.reshape(B, n_blk, Q_BLOCK, DIFF_HEADS, 2, DIFF_HEAD_DIM), 1, 0)
        o_x = lax.map(lambda qb: _diff_attend(qb, k_all, v_all, lam), q_blk)
        o_x = jnp.moveaxis(o_x, 0, 1).reshape(B, T, DIFF_HEADS, DIFF_V_DIM)
        yb_x = _diff_out(o_x, diff_subln_g[l], lam_init)

        mix_x = _gated_merge(ya_x, yb_x, gx, branch_up_a[l], branch_up_b[l], mix_w_out[l])
        x = x + m_x[..., 5, :] * _rms(mix_x, post_norm_g[l, 1])

        if not last:
            yb_c = _diff_out(_diff_attend(qc, kc, vc, lam), diff_subln_g[l], lam_init)
            mix_c = _gated_merge(ya_c, yb_c, gc, branch_up_a[l], branch_up_b[l], mix_w_out[l])
            ctx = ctx + m_c[..., 5, :] * _rms(mix_c, post_norm_g[l, 1])
            ctx = _ffn_half_step(ctx, m_c[..., 6:9, :], pre_norm_g[l, 2], post_norm_g[l, 2],
                                 ffn2_w_in[l], ffn2_w_out[l])

        x = _ffn_half_step(x, m_x[..., 6:9, :], pre_norm_g[l, 2], post_norm_g[l, 2],
                           ffn2_w_in[l], ffn2_w_out[l])
    return x
```

```cpp
#include <hip/hip_runtime.h>
#include <hip/hip_cooperative_groups.h>
#include <cstdio>
#include <cstdint>
namespace cg = cooperative_groups;

typedef unsigned short bf16_t;
typedef short bf16x8 __attribute__((ext_vector_type(8)));
typedef short s16x4 __attribute__((ext_vector_type(4)));
typedef float f32x2 __attribute__((ext_vector_type(2)));
typedef float f32x4 __attribute__((ext_vector_type(4)));
typedef float f32x16 __attribute__((ext_vector_type(16)));
typedef unsigned u32x2 __attribute__((ext_vector_type(2)));
typedef unsigned u32x4 __attribute__((ext_vector_type(4)));
typedef __bf16 bf16x2_t __attribute__((ext_vector_type(2)));
typedef short v4i16_t __attribute__((ext_vector_type(4)));
#define LAS __attribute__((address_space(3)))
#define DI __device__ __forceinline__

DI unsigned pk2(float lo, float hi) { f32x2 v = {lo, hi}; bf16x2_t b = __builtin_convertvector(v, bf16x2_t); return __builtin_bit_cast(unsigned, b); }
DI float bflo(unsigned u) { return __builtin_bit_cast(float, u << 16); }
DI float bfhi(unsigned u) { return __builtin_bit_cast(float, u & 0xffff0000u); }
DI float wave_sum(float v) {
    v += __builtin_bit_cast(float, __builtin_amdgcn_update_dpp(0, __builtin_bit_cast(int, v), 0xB1, 0xF, 0xF, true));
    v += __builtin_bit_cast(float, __builtin_amdgcn_update_dpp(0, __builtin_bit_cast(int, v), 0x4E, 0xF, 0xF, true));
    v += __builtin_bit_cast(float, __builtin_amdgcn_update_dpp(0, __builtin_bit_cast(int, v), 0x141, 0xF, 0xF, true));
    v += __builtin_bit_cast(float, __builtin_amdgcn_update_dpp(0, __builtin_bit_cast(int, v), 0x140, 0xF, 0xF, true));
    const int vi = __builtin_bit_cast(int, v);
    const float r0 = __builtin_bit_cast(float, __builtin_amdgcn_readlane(vi, 0)), r1 = __builtin_bit_cast(float, __builtin_amdgcn_readlane(vi, 16));
    const float r2 = __builtin_bit_cast(float, __builtin_amdgcn_readlane(vi, 32)), r3 = __builtin_bit_cast(float, __builtin_amdgcn_readlane(vi, 48));
    return (r0 + r1) + (r2 + r3);
}
DI float dpp_f(float x, const int ctrl_sel) {
    int xi = __builtin_bit_cast(int, x);
    int r;
    if (ctrl_sel == 0) r = __builtin_amdgcn_update_dpp(0, xi, 0xB1, 0xF, 0xF, true);
    else if (ctrl_sel == 1) r = __builtin_amdgcn_update_dpp(0, xi, 0x4E, 0xF, 0xF, true);
    else r = __builtin_amdgcn_update_dpp(0, xi, 0x141, 0xF, 0xF, true);
    return __builtin_bit_cast(float, r);
}
DI float sum8(float x) { x += dpp_f(x, 0); x += dpp_f(x, 1); x += dpp_f(x, 2); return x; }
DI float fast_sigmoid(float x) { return __builtin_amdgcn_rcpf(1.f + __builtin_amdgcn_exp2f(-1.4426950408889634f * x)); }
DI float fma_s(float a, float b, float c) { float d; asm("v_fma_f32 %0, %1, %2, %3" : "=v"(d) : "v"(a), "v"(b), "v"(c)); return d; }
DI float nfma_s(float a, float b, float c) { float d; asm("v_fma_f32 %0, -%1, %2, %3" : "=v"(d) : "v"(a), "v"(b), "v"(c)); return d; }
DI float mul_s(float a, float b) { float d; asm("v_mul_f32_e32 %0, %1, %2" : "=v"(d) : "v"(a), "v"(b)); return d; }
DI float max3_s(float a, float b, float c) { float d; asm("v_max3_f32 %0, %1, %2, %3" : "=v"(d) : "v"(a), "v"(b), "v"(c)); return d; }
DI int crow(int r, int hi) { return (r & 3) + 8 * (r >> 2) + 4 * hi; }

constexpr int D = 1024, NB = 16, T = 2048, CT = 256, DFF = 2816;
constexpr int ML = NB * T;
constexpr int MC = NB * CT;
constexpr int MA = ML + MC;
constexpr int UP = 3584;
constexpr float EPS = 1e-6f;
constexpr size_t MiB = 1u << 20;
constexpr size_t WS_MOD = 0;
constexpr size_t WS_W1IN = 1 * MiB, WS_W1OUT = 12 * MiB, WS_WMIX = 18 * MiB, WS_WUPA = 29 * MiB, WS_WUPB = 30 * MiB, WS_WOUT = 31 * MiB;
constexpr size_t WS_W2IN = 33 * MiB, WS_W2OUT = 44 * MiB, WS_WG2 = 49 * MiB + 512 * 1024;
constexpr size_t WS_H = 50 * MiB, WS_F = 122 * MiB, WS_ACT = 194 * MiB, WS_U = 122 * MiB, WS_Y = 374 * MiB, WS_BON = 438 * MiB;
constexpr size_t WS_G = 440 * MiB, WS_O = 472 * MiB, WS_AG = 1 * MiB, WS_UG = 122 * MiB, WS_MG = 250 * MiB, WS_F2 = 50 * MiB, WS_H3 = 122 * MiB;
constexpr size_t WS_ACT2 = 194 * MiB, WS_END = 504 * MiB;
constexpr int LDS_BYTES = 163840;
constexpr size_t WS_BAR = 768 * 1024;
constexpr int LDS_BARST = 163072;

#ifndef PROBE_BITS
#define PROBE_BITS 0
#endif
struct Args { const float* in[29]; float* out; unsigned char* ws; int ph_lo, ph_hi; };

namespace pg8 {
constexpr int BM = 256, BK = 64, HALF = 128, HTB = HALF * BK * 2, NXCD = 8, WGM = 8;
DI int lds_byte(int r, int c) { const int st = (r >> 4) * 2 + (c >> 5), rr = r & 15, cc = c & 31, ob = rr * 64 + cc * 2; return st * 1024 + (ob ^ (((ob >> 9) & 1) << 5)); }
DI void stage_rc(int b, int& R, int& C) { const int st = b / 1024, sb = b % 1024, swz = sb ^ (((sb >> 9) & 1) << 5); R = (st >> 1) * 16 + swz / 64; C = (st & 1) * 32 + (swz % 64) / 2; }
DI int perm32(int rho) { const int n = rho >> 4, i = rho & 15; return 8 * (i >> 2) + 4 * n + (i & 3); }
struct Unit { int pm, pn; };
struct Gemm { const bf16_t* A; const bf16_t* Bt; int M, N, K; };
struct StaticOrder {
    int nM, nN, nwg, G, c;
    DI void init(int M, int N, int G_, int c_) { nM = M / BM; nN = N / BM; nwg = nM * nN; G = G_; c = c_; }
    DI bool next(int i, Unit& u) const {
        const long L = (long)i * G + c; if (L >= nwg) return false;
        int wgid = (int)L; { const int q = nwg / NXCD, r = nwg % NXCD, xcd = wgid % NXCD, off = wgid / NXCD; wgid = (xcd < r ? xcd * (q + 1) : r * (q + 1) + (xcd - r) * q) + off; }
        const int nig = WGM * nN, gid = wgid / nig, fm = gid * WGM, gsz = (nM - fm) < WGM ? (nM - fm) : WGM;
        u.pm = fm + ((wgid % nig) % gsz); u.pn = (wgid % nig) / gsz; return true;
    }
    DI void a_ready(const Unit&) const {}
    DI void done(const Unit&) const {}
};

template <int MODE> struct Epi {
    static constexpr bool PERM = true, AFTER_DRAIN = false;
    bf16_t* O; int ldc; const bf16_t* G; int ldg;
    DI void operator()(const f32x4 (&acc)[2][2][4][2], const Unit& u, int wr, int wc, int fr, int fq) const {
        const int row0 = u.pm * BM + wr * 64 + fr;
#pragma unroll
        for (int ai = 0; ai < 2; ++ai)
#pragma unroll
            for (int m = 0; m < 4; ++m) {
                const size_t row = (size_t)(row0 + ai * HALF + m * 16);
                if (MODE == 1) {
                    const int col = u.pn * 128 + wc * 32 + 8 * fq;
                    float v[8];
#pragma unroll
                    for (int n = 0; n < 2; ++n)
#pragma unroll
                        for (int j = 0; j < 4; ++j) { const float g = acc[ai][0][m][n][j], up = acc[ai][1][m][n][j]; v[4 * n + j] = (g * up) * __builtin_amdgcn_rcpf(1.f + __builtin_amdgcn_exp2f(g)); }
                    u32x4 w; w.x = pk2(v[0], v[1]); w.y = pk2(v[2], v[3]); w.z = pk2(v[4], v[5]); w.w = pk2(v[6], v[7]);
                    *(u32x4*)(O + row * ldc + col) = w;
                } else {
#pragma unroll
                    for (int bj = 0; bj < 2; ++bj) {
                        const int col = u.pn * BM + bj * HALF + wc * 32 + 8 * fq;
                        float v[8];
#pragma unroll
                        for (int n = 0; n < 2; ++n)
#pragma unroll
                            for (int j = 0; j < 4; ++j) v[4 * n + j] = acc[ai][bj][m][n][j];
                        if (MODE == 2) {
#pragma unroll
                            for (int j = 0; j < 8; ++j) v[j] = fast_sigmoid(v[j]);
                        }
                        if (MODE == 3 || MODE == 4) {
                            const u32x4 g = *(const u32x4*)(G + row * ldg + (MODE == 4 ? 1024 : 0) + col);
                            v[0] *= bflo(g.x); v[1] *= bfhi(g.x); v[2] *= bflo(g.y); v[3] *= bfhi(g.y); v[4] *= bflo(g.z); v[5] *= bfhi(g.z); v[6] *= bflo(g.w); v[7] *= bfhi(g.w);
                        }
                        if (MODE == 4) {
                            const u32x4 p = *(const u32x4*)(O + row * ldc + col);
                            v[0] += bflo(p.x); v[1] += bfhi(p.x); v[2] += bflo(p.y); v[3] += bfhi(p.y); v[4] += bflo(p.z); v[5] += bfhi(p.z); v[6] += bflo(p.w); v[7] += bfhi(p.w);
                        }
                        u32x4 w; w.x = pk2(v[0], v[1]); w.y = pk2(v[2], v[3]); w.z = pk2(v[4], v[5]); w.w = pk2(v[6], v[7]);
                        *(u32x4*)(O + row * ldc + col) = w;
                    }
                }
            }
    }
};

template <class EpiT, class Sched, bool ALIGN_EPI = false, bool SP2 = false>
DI void gemm_phase(LAS unsigned char* lds, const Gemm g, const Sched& S, const EpiT& E) {
    const int tid = threadIdx.x, wid = __builtin_amdgcn_readfirstlane(tid >> 6), lane = tid & 63, wr = wid >> 2, wc = wid & 3, fr = lane & 15, fq = lane >> 4;
    const int K = g.K, nt = K / BK;
    unsigned voffA[2], voffB[2];
#pragma unroll
    for (int i = 0; i < 2; ++i) { int R, C; stage_rc(tid * 16 + i * 8192, R, C); const int Rb = EpiT::PERM ? ((R & ~31) + perm32(R & 31)) : R;
        voffA[i] = (unsigned)(R * K + C) * 2u; voffB[i] = (unsigned)(Rb * K + C) * 2u; }
    const size_t kstep = (size_t)(BK * 2);
    const size_t hstep = (size_t)HALF * K * 2;
    const size_t tstep = 2 * hstep;
    const unsigned ldsw = (unsigned)wid * 1024u;
    const int aoff = lds_byte(wr * 64 + fr, fq * 8), boff = lds_byte(wc * 32 + fr, fq * 8);
#define PG8_SA(b, h) (((b) * 2 + (h)) * HTB)
#define PG8_SB(b, h) ((4 + (b) * 2 + (h)) * HTB)
#define PG8_STAGE(bufoff, gbase, voff) do { _Pragma("unroll") for (int _i = 0; _i < 2; ++_i) \
        __builtin_amdgcn_global_load_lds((const unsigned*)((const char*)(gbase) + (voff)[_i]), (LAS unsigned*)(lds + (bufoff) + ldsw + _i * 8192), 16, 0, 0); } while (0)
#define PG8_LDA(dst, b, h) do { _Pragma("unroll") for (int m = 0; m < 4; ++m) _Pragma("unroll") for (int k = 0; k < 2; ++k) dst[m][k] = *(const LAS bf16x8*)(lds + PG8_SA(b, h) + aoff + m * 2048 + k * 1024); } while (0)
#define PG8_LDB(dst, b, h) do { _Pragma("unroll") for (int n = 0; n < 2; ++n) _Pragma("unroll") for (int k = 0; k < 2; ++k) dst[n][k] = *(const LAS bf16x8*)(lds + PG8_SB(b, h) + boff + n * 2048 + k * 1024); } while (0)
#define PG8_MMA(ai, bj, At, Bt) do { __builtin_amdgcn_s_setprio(1); _Pragma("unroll") for (int m = 0; m < 4; ++m) _Pragma("unroll") for (int n = 0; n < 2; ++n) _Pragma("unroll") for (int k = 0; k < 2; ++k) \
        acc[ai][bj][m][n] = __builtin_amdgcn_mfma_f32_16x16x32_bf16(Bt[n][k], At[m][k], acc[ai][bj][m][n], 0, 0, 0); __builtin_amdgcn_s_setprio(0); } while (0)
#define PG8_WAIT_V(n) asm volatile("s_waitcnt vmcnt(" #n ")" ::: "memory")
#define PG8_WAIT_L(n) asm volatile("s_waitcnt lgkmcnt(" #n ")" ::: "memory")
#define PG8_BAR __builtin_amdgcn_s_barrier()
#define PG8_SCHED __builtin_amdgcn_sched_barrier(0)
    Unit cur, nxt; int ui = 0;
    if (!S.next(0, cur)) return;
    f32x4 acc[2][2][4][2];
#pragma unroll
    for (int a = 0; a < 2; ++a)
#pragma unroll
        for (int b = 0; b < 2; ++b)
#pragma unroll
            for (int m = 0; m < 4; ++m)
#pragma unroll
                for (int n = 0; n < 2; ++n) acc[a][b][m][n] = (f32x4){0.f, 0.f, 0.f, 0.f};
    bf16x8 At[4][2], B0[2][2], B1[2][2];
    const char* cA = (const char*)g.A + (size_t)cur.pm * tstep; const char* cB = (const char*)g.Bt + (size_t)cur.pn * tstep;
    S.a_ready(cur);
    if constexpr (SP2) {
        PG8_STAGE(PG8_SB(0, 0), cB, voffB); PG8_STAGE(PG8_SB(0, 1), cB + hstep, voffB); PG8_STAGE(PG8_SA(0, 0), cA, voffA); PG8_STAGE(PG8_SA(0, 1), cA + hstep, voffA);
        if (wr == 1) PG8_BAR;
        PG8_WAIT_V(2); PG8_BAR;
        PG8_STAGE(PG8_SB(1, 0), cB + kstep, voffB); PG8_STAGE(PG8_SA(1, 0), cA + kstep, voffA); PG8_STAGE(PG8_SB(1, 1), cB + hstep + kstep, voffB);
        PG8_WAIT_V(6); PG8_BAR;
    } else {
        PG8_STAGE(PG8_SB(0, 0), cB, voffB); PG8_STAGE(PG8_SA(0, 0), cA, voffA); PG8_STAGE(PG8_SB(0, 1), cB + hstep, voffB); PG8_STAGE(PG8_SA(0, 1), cA + hstep, voffA);
        if (wr == 1) PG8_BAR;
        PG8_WAIT_V(4); PG8_BAR;
        PG8_STAGE(PG8_SB(1, 0), cB + kstep, voffB); PG8_STAGE(PG8_SA(1, 0), cA + kstep, voffA); PG8_STAGE(PG8_SB(1, 1), cB + hstep + kstep, voffB);
        PG8_WAIT_V(6); PG8_BAR;
    }
    for (;;) {
        const bool has_next = S.next(ui + 1, nxt);
        const char* nA = has_next ? (const char*)g.A + (size_t)nxt.pm * tstep : cA; const char* nB = has_next ? (const char*)g.Bt + (size_t)nxt.pn * tstep : cB;
        for (int t = 0; t < nt; t += 2) {
            const bool last = (t == nt - 2);
            const char* a1 = cA + (size_t)(t + 1) * kstep;
            const char* a2 = last ? nA : cA + (size_t)(t + 2) * kstep; const char* b2 = last ? nB : cB + (size_t)(t + 2) * kstep;
            const char* a3 = a2 + kstep; const char* b3 = b2 + kstep;
            if (last && has_next) S.a_ready(nxt);
            if constexpr (SP2) {
            PG8_LDB(B0, 0, 0); PG8_LDB(B1, 0, 1); PG8_SCHED; PG8_LDA(At, 0, 0); PG8_STAGE(PG8_SA(1, 1), a1 + hstep, voffA);
            PG8_WAIT_V(8); PG8_WAIT_L(0); PG8_BAR; PG8_MMA(0, 0, At, B0); PG8_MMA(0, 1, At, B1); PG8_BAR; PG8_SCHED;
            PG8_LDA(At, 0, 1); PG8_STAGE(PG8_SB(0, 0), b2, voffB); PG8_STAGE(PG8_SB(0, 1), b2 + hstep, voffB); PG8_STAGE(PG8_SA(0, 0), a2, voffA);
            PG8_WAIT_V(8); PG8_WAIT_L(0); PG8_BAR; PG8_MMA(1, 0, At, B0); PG8_MMA(1, 1, At, B1); PG8_BAR; PG8_SCHED;
            PG8_LDB(B0, 1, 0); PG8_LDB(B1, 1, 1); PG8_SCHED; PG8_LDA(At, 1, 0); PG8_STAGE(PG8_SA(0, 1), a2 + hstep, voffA);
            PG8_WAIT_V(8); PG8_WAIT_L(0); PG8_BAR; PG8_MMA(0, 0, At, B0); PG8_MMA(0, 1, At, B1); PG8_BAR; PG8_SCHED;
            PG8_LDA(At, 1, 1); PG8_STAGE(PG8_SB(1, 0), b3, voffB); PG8_STAGE(PG8_SB(1, 1), b3 + hstep, voffB); PG8_STAGE(PG8_SA(1, 0), a3, voffA);
            PG8_WAIT_V(8); PG8_WAIT_L(0); PG8_BAR; PG8_MMA(1, 0, At, B0); PG8_MMA(1, 1, At, B1); PG8_BAR; PG8_SCHED;
            } else {
            PG8_LDB(B0, 0, 0); PG8_SCHED; PG8_LDA(At, 0, 0); PG8_STAGE(PG8_SA(1, 1), a1 + hstep, voffA);
            PG8_WAIT_L(8); PG8_BAR; PG8_WAIT_L(0); PG8_MMA(0, 0, At, B0); PG8_BAR; PG8_SCHED;
            PG8_LDB(B1, 0, 1); PG8_STAGE(PG8_SB(0, 0), b2, voffB);
            PG8_BAR; PG8_WAIT_L(0); PG8_MMA(0, 1, At, B1); PG8_BAR;
            PG8_LDA(At, 0, 1); PG8_STAGE(PG8_SA(0, 0), a2, voffA);
            PG8_BAR; PG8_WAIT_L(0); PG8_MMA(1, 0, At, B0); PG8_BAR; PG8_SCHED;
            PG8_STAGE(PG8_SB(0, 1), b2 + hstep, voffB);
            PG8_WAIT_V(6); PG8_BAR; PG8_MMA(1, 1, At, B1); PG8_BAR;
            PG8_LDB(B0, 1, 0); PG8_SCHED; PG8_LDA(At, 1, 0); PG8_STAGE(PG8_SA(0, 1), a2 + hstep, voffA);
            PG8_WAIT_L(8); PG8_BAR; PG8_WAIT_L(0); PG8_MMA(0, 0, At, B0); PG8_BAR; PG8_SCHED;
            PG8_LDB(B1, 1, 1); PG8_STAGE(PG8_SB(1, 0), b3, voffB);
            PG8_BAR; PG8_WAIT_L(0); PG8_MMA(0, 1, At, B1); PG8_BAR;
            PG8_LDA(At, 1, 1); PG8_STAGE(PG8_SA(1, 0), a3, voffA);
            PG8_BAR; PG8_WAIT_L(0); PG8_MMA(1, 0, At, B0); PG8_BAR; PG8_SCHED;
            PG8_STAGE(PG8_SB(1, 1), b3 + hstep, voffB);
            PG8_WAIT_V(6); PG8_BAR; PG8_MMA(1, 1, At, B1); PG8_BAR;
            }
        }
        if constexpr (ALIGN_EPI) { if (wr == 0) PG8_BAR; }
        if constexpr (!EpiT::AFTER_DRAIN) { E(acc, cur, wr, wc, fr, fq); S.done(cur); }
        if (!has_next) break;
#pragma unroll
        for (int a = 0; a < 2; ++a)
#pragma unroll
            for (int b = 0; b < 2; ++b)
#pragma unroll
                for (int m = 0; m < 4; ++m)
#pragma unroll
                    for (int n = 0; n < 2; ++n) acc[a][b][m][n] = (f32x4){0.f, 0.f, 0.f, 0.f};
        cur = nxt; cA = nA; cB = nB; ++ui;
        if constexpr (ALIGN_EPI) { if (wr == 1) PG8_BAR; }
    }
    PG8_WAIT_V(0);
    if constexpr (!ALIGN_EPI) { if (wr == 0) PG8_BAR; }
    PG8_BAR;
#undef PG8_SA
#undef PG8_SB
#undef PG8_STAGE
#undef PG8_LDA
#undef PG8_LDB
#undef PG8_MMA
#undef PG8_WAIT_V
#undef PG8_WAIT_L
#undef PG8_BAR
#undef PG8_SCHED
}
}

template <int MODE>
DI void run_gemm(LAS unsigned char* lds, const bf16_t* A, const bf16_t* Bt, int M, int N, int K, bf16_t* O, int ldc, const bf16_t* G, int ldg) {
    pg8::Gemm g{A, Bt, M, N, K}; pg8::StaticOrder S; S.init(M, N, (int)gridDim.x, (int)blockIdx.x);
    pg8::Epi<MODE> E{O, ldc, G, ldg};
    pg8::gemm_phase<pg8::Epi<MODE>, pg8::StaticOrder, true, true>(lds, g, S, E);
    __syncthreads();
}

DI int rowmap(int mode, int n) {
    if (mode == 1) { const int g = n >= DFF ? 1 : 0; const int j = n - g * DFF; return (j >> 7) * 256 + g * 128 + (j & 127); }
    if (mode == 2) return n < 1920 ? n : n + 128;
    return n;
}
DI void transpose_item(const float* W, int N, bf16_t* WT, int KP, int mode, LAS float* scr, int item, int lane) {
    const int nblk = N / 32, kb = item / nblk, nb = item % nblk, k0 = 64 * kb, n0 = 32 * nb;
#pragma unroll 8
    for (int i = 0; i < 32; ++i) { const int kk = 2 * i + (lane >> 5); scr[kk * 33 + (lane & 31)] = W[(size_t)(k0 + kk) * N + n0 + (lane & 31)]; }
    asm volatile("s_waitcnt lgkmcnt(0)" ::: "memory");
    const int c = lane & 7;
    const float wsc = mode == 1 ? (n0 < DFF ? -1.4426950408889634f : -0.6931471805599453f) : 1.f;
#pragma unroll
    for (int j = 0; j < 4; ++j) { const int n = (lane >> 3) + 8 * j; const LAS float* s = scr + (8 * c) * 33 + n;
        u32x4 o; o.x = pk2(s[0 * 33] * wsc, s[1 * 33] * wsc); o.y = pk2(s[2 * 33] * wsc, s[3 * 33] * wsc); o.z = pk2(s[4 * 33] * wsc, s[5 * 33] * wsc); o.w = pk2(s[6 * 33] * wsc, s[7 * 33] * wsc);
        *(u32x4*)(WT + (size_t)rowmap(mode, n0 + n) * KP + k0 + 8 * c) = o; }
    asm volatile("s_waitcnt lgkmcnt(0)" ::: "memory");
}

DI void p0_phase(const Args& a, LAS unsigned char* lds, int tid, int lane, int wave) {
    unsigned char* ws = a.ws;
    {
        const float* c = a.in[1]; const float* cctx = a.in[3]; const float* ada_w = a.in[4]; const float* ada_b = a.in[5];
        float* MOD = (float*)(ws + WS_MOD);
        LAS float* Sx = (LAS float*)lds;
        LAS float* RED = (LAS float*)(lds + 81920);
        for (int item = blockIdx.x; item < 144; item += gridDim.x) {
            for (int idx = tid; idx < 1024 * 20; idx += 512) { const int k = idx / 20, i = idx % 20; float v = 0.f;
                if (i < 16) v = c[i * 1024 + k]; else if (i == 16) v = cctx[k];
                Sx[idx] = v / (1.f + __expf(-v)); }
            __syncthreads();
            const int n0 = item * 64;
            float acc[17];
#pragma unroll
            for (int i = 0; i < 17; ++i) acc[i] = 0.f;
            for (int k = wave * 128; k < wave * 128 + 128; ++k) {
                const float wv = ada_w[(size_t)k * 9216 + n0 + lane];
                const LAS f32x4* sp = (const LAS f32x4*)(Sx + k * 20);
                const f32x4 s0 = sp[0], s1 = sp[1], s2 = sp[2], s3 = sp[3]; const float s16 = Sx[k * 20 + 16];
#pragma unroll
                for (int j = 0; j < 4; ++j) { acc[j] += s0[j] * wv; acc[4 + j] += s1[j] * wv; acc[8 + j] += s2[j] * wv; acc[12 + j] += s3[j] * wv; }
                acc[16] += s16 * wv;
            }
#pragma unroll
            for (int i = 0; i < 17; ++i) RED[(wave * 17 + i) * 64 + lane] = acc[i];
            __syncthreads();
            for (int idx = tid; idx < 17 * 64; idx += 512) { const int i = idx / 64, n = idx % 64; float s = 0.f;
#pragma unroll
                for (int w = 0; w < 8; ++w) s += RED[(w * 17 + i) * 64 + n];
                MOD[i * 9216 + n0 + n] = s + ada_b[n0 + n]; }
            __syncthreads();
        }
    }
    {
        LAS float* scr = (LAS float*)(lds + wave * 8448);
        const int gw = blockIdx.x * 8 + wave, NGW = gridDim.x * 8;
        constexpr int I1 = 16 * 176, I2 = 44 * 32, I3 = 16 * 172, I4 = 8 * 32, I6 = 16 * 32, I9 = 2 * 16;
        constexpr int NITEMS = I1 + I2 + I3 + I4 + I4 + I6 + I1 + I2 + I9;
        for (int it = gw; it < NITEMS; it += NGW) {
            int r = it;
            if (r < I1) { transpose_item(a.in[8], 2 * DFF, (bf16_t*)(ws + WS_W1IN), 1024, 1, scr, r, lane); continue; } r -= I1;
            if (r < I2) { transpose_item(a.in[9], 1024, (bf16_t*)(ws + WS_W1OUT), DFF, 0, scr, r, lane); continue; } r -= I2;
            if (r < I3) { transpose_item(a.in[10], 5504, (bf16_t*)(ws + WS_WMIX), 1024, 2, scr, r, lane); continue; } r -= I3;
            if (r < I4) { transpose_item(a.in[24], 1024, (bf16_t*)(ws + WS_WUPA), 512, 0, scr, r, lane); continue; } r -= I4;
            if (r < I4) { transpose_item(a.in[25], 1024, (bf16_t*)(ws + WS_WUPB), 512, 0, scr, r, lane); continue; } r -= I4;
            if (r < I6) { transpose_item(a.in[26], 1024, (bf16_t*)(ws + WS_WOUT), 1024, 0, scr, r, lane); continue; } r -= I6;
            if (r < I1) { transpose_item(a.in[27], 2 * DFF, (bf16_t*)(ws + WS_W2IN), 1024, 1, scr, r, lane); continue; } r -= I1;
            if (r < I2) { transpose_item(a.in[28], 1024, (bf16_t*)(ws + WS_W2OUT), DFF, 0, scr, r, lane); continue; } r -= I2;
            transpose_item(a.in[16], 512, (bf16_t*)(ws + WS_WG2), 256, 0, scr, r, lane);
        }
        const int gt = blockIdx.x * 512 + tid, NGT = gridDim.x * 512;
        const u32x4 z = {0u, 0u, 0u, 0u};
        for (int i = gt; i < 128 * 1024 / 8; i += NGT) *(u32x4*)(ws + WS_WMIX + (size_t)1920 * 1024 * 2 + (size_t)i * 16) = z;
        for (int i = gt; i < 512 * 16; i += NGT) { const int rr = i >> 4, cc = i & 15; *(u32x4*)(ws + WS_WG2 + (size_t)rr * 512 + 256 + cc * 16) = z; }
    }
}

template <bool HAS_F, bool WRITE_X, bool WRITE_H, bool XIN_BF = false, bool XOUT_BF = false>
DI void rowpass(const void* xin, const bf16_t* f, const float* postg, const float* gate, float alpha, void* xout,
                const float* preg, const float* shift, const float* scale, bf16_t* hout, int lane) {
    f32x4 v[4];
#pragma unroll
    for (int j = 0; j < 4; ++j) {
        if (XIN_BF) { const u32x2 raw = ((const u32x2*)xin)[lane + 64 * j]; v[j] = (f32x4){bflo(raw.x), bfhi(raw.x), bflo(raw.y), bfhi(raw.y)}; }
        else v[j] = ((const f32x4*)xin)[lane + 64 * j];
    }
    if (HAS_F) {
        f32x4 fv[4]; float s = 0.f;
#pragma unroll
        for (int j = 0; j < 4; ++j) { const u32x2 raw = ((const u32x2*)f)[lane + 64 * j]; fv[j] = (f32x4){bflo(raw.x), bfhi(raw.x), bflo(raw.y), bfhi(raw.y)};
            s += (fv[j].x * fv[j].x + fv[j].y * fv[j].y) + (fv[j].z * fv[j].z + fv[j].w * fv[j].w); }
        const float rs = alpha * rsqrtf(wave_sum(s) * (1.f / 1024.f) + EPS);
#pragma unroll
        for (int j = 0; j < 4; ++j) { const f32x4 pg = ((const f32x4*)postg)[lane + 64 * j], gt = ((const f32x4*)gate)[lane + 64 * j]; v[j] += rs * gt * fv[j] * pg; }
    }
    if (WRITE_X) {
#pragma unroll
        for (int j = 0; j < 4; ++j) {
            if (XOUT_BF) { u32x2 o; o.x = pk2(v[j].x, v[j].y); o.y = pk2(v[j].z, v[j].w); ((u32x2*)xout)[lane + 64 * j] = o; }
            else ((f32x4*)xout)[lane + 64 * j] = v[j];
        }
    }
    if (WRITE_H) {
        float s2 = 0.f;
#pragma unroll
        for (int j = 0; j < 4; ++j) s2 += (v[j].x * v[j].x + v[j].y * v[j].y) + (v[j].z * v[j].z + v[j].w * v[j].w);
        const float rstd = rsqrtf(wave_sum(s2) * (1.f / 1024.f) + EPS);
#pragma unroll
        for (int j = 0; j < 4; ++j) { const f32x4 g = ((const f32x4*)preg)[lane + 64 * j], sc = ((const f32x4*)scale)[lane + 64 * j], sh = ((const f32x4*)shift)[lane + 64 * j];
            const f32x4 hv = v[j] * rstd * g * (1.f + sc) + sh;
            u32x2 o; o.x = pk2(hv.x, hv.y); o.y = pk2(hv.z, hv.w);
            ((u32x2*)hout)[lane + 64 * j] = o; }
    }
}

template <bool HAS_F, bool WRITE_X, bool WRITE_H, bool XIN_BF, bool XOUT_BF>
DI void rowpass_block(int r0, int r1, const void* xin, const bf16_t* f, const float* postg, const float* MODv, int mod_fixed, int goff, float alpha, void* xout,
                      const float* preg, int shoff, int scoff, bf16_t* hout, int lane) {
    if (r0 >= r1) return;
    f32x4 Av[4], Bv[4], Cv[4];
    int curb = -2;
    f32x4 xr0[4], xr1[4]; u32x2 xb0[4], xb1[4], fr0[4], fr1[4];
#define RB_LOAD(rr, XR, XB, FR) do { _Pragma("unroll") for (int j = 0; j < 4; ++j) { \
        if (XIN_BF) XB[j] = ((const u32x2*)((const bf16_t*)xin + (size_t)(rr) * D))[lane + 64 * j]; else XR[j] = ((const f32x4*)((const float*)xin + (size_t)(rr) * D))[lane + 64 * j]; \
        if (HAS_F) FR[j] = ((const u32x2*)(f + (size_t)(rr) * D))[lane + 64 * j]; } } while (0)
#define RB_ROW(row, XR, XB, FR) do { \
        const int bi = mod_fixed >= 0 ? mod_fixed : (row) / T; \
        if (bi != curb) { \
            curb = bi; const float* m = MODv + (size_t)bi * 9216; \
            _Pragma("unroll") for (int j = 0; j < 4; ++j) { \
                if (HAS_F) Av[j] = alpha * ((const f32x4*)(m + goff))[lane + 64 * j] * ((const f32x4*)postg)[lane + 64 * j]; \
                if (WRITE_H) { Bv[j] = ((const f32x4*)preg)[lane + 64 * j] * (1.f + ((const f32x4*)(m + scoff))[lane + 64 * j]); Cv[j] = ((const f32x4*)(m + shoff))[lane + 64 * j]; } \
            } \
        } \
        f32x4 v[4], fv[4]; \
        _Pragma("unroll") for (int j = 0; j < 4; ++j) { \
            if (XIN_BF) v[j] = (f32x4){bflo(XB[j].x), bfhi(XB[j].x), bflo(XB[j].y), bfhi(XB[j].y)}; else v[j] = XR[j]; \
            if (HAS_F) fv[j] = (f32x4){bflo(FR[j].x), bfhi(FR[j].x), bflo(FR[j].y), bfhi(FR[j].y)}; \
        } \
        if ((row) + 2 < r1) RB_LOAD((row) + 2, XR, XB, FR); \
        if (HAS_F) { \
            float sq = 0.f; \
            _Pragma("unroll") for (int j = 0; j < 4; ++j) sq += (fv[j].x * fv[j].x + fv[j].y * fv[j].y) + (fv[j].z * fv[j].z + fv[j].w * fv[j].w); \
            const float rs = rsqrtf(wave_sum(sq) * (1.f / 1024.f) + EPS); \
            _Pragma("unroll") for (int j = 0; j < 4; ++j) v[j] += rs * Av[j] * fv[j]; \
        } \
        if (WRITE_X) { \
            _Pragma("unroll") for (int j = 0; j < 4; ++j) { \
                if (XOUT_BF) { u32x2 o; o.x = pk2(v[j].x, v[j].y); o.y = pk2(v[j].z, v[j].w); ((u32x2*)((bf16_t*)xout + (size_t)(row) * D))[lane + 64 * j] = o; } \
                else ((f32x4*)((float*)xout + (size_t)(row) * D))[lane + 64 * j] = v[j]; \
            } \
        } \
        if (WRITE_H) { \
            float s2 = 0.f; \
            _Pragma("unroll") for (int j = 0; j < 4; ++j) s2 += (v[j].x * v[j].x + v[j].y * v[j].y) + (v[j].z * v[j].z + v[j].w * v[j].w); \
            const float rstd = rsqrtf(wave_sum(s2) * (1.f / 1024.f) + EPS); \
            _Pragma("unroll") for (int j = 0; j < 4; ++j) { const f32x4 hv = v[j] * rstd * Bv[j] + Cv[j]; u32x2 o; o.x = pk2(hv.x, hv.y); o.y = pk2(hv.z, hv.w); ((u32x2*)(hout + (size_t)(row) * D))[lane + 64 * j] = o; } \
        } } while (0)
    RB_LOAD(r0, xr0, xb0, fr0);
    if (r0 + 1 < r1) RB_LOAD(r0 + 1, xr1, xb1, fr1);
    for (int row = r0; row < r1; row += 2) {
        RB_ROW(row, xr0, xb0, fr0);
        if (row + 1 < r1) RB_ROW(row + 1, xr1, xb1, fr1);
    }
#undef RB_ROW
#undef RB_LOAD
}
DI void wave_rows(int n, int w, int nw, int& r0, int& r1) { const int per = (n + nw - 1) / nw; r0 = w * per; r1 = r0 + per < n ? r0 + per : n; }

DI void prep_phase(const Args& a, int lane, int wave) {
    bf16_t* U = (bf16_t*)(a.ws + WS_U); bf16_t* AG = (bf16_t*)(a.ws + WS_AG);
    const float* shw = a.in[11];
    const int gw = blockIdx.x * 8 + wave, NGW = gridDim.x * 8;
    for (int row = gw; row < ML; row += NGW) {
        const int t = row & (T - 1);
        bf16_t* ur = U + (size_t)row * UP;
        u32x2 o = {0u, 0u};
        if (lane < 32) {
            const int col = 1792 + 4 * lane;
            const u32x2 cu = *(const u32x2*)(ur + col);
            u32x2 pv = {0u, 0u}, nx = {0u, 0u};
            if (t > 0) pv = *(const u32x2*)(ur - UP + col);
            if (t < T - 1) nx = *(const u32x2*)(ur + UP + col);
            const f32x4 w0 = *(const f32x4*)(shw + col), w1 = *(const f32x4*)(shw + 1920 + col), w2 = *(const f32x4*)(shw + 3840 + col);
            const float v0 = bflo(pv.x) * w0.x + bflo(cu.x) * w1.x + bflo(nx.x) * w2.x;
            const float v1 = bfhi(pv.x) * w0.y + bfhi(cu.x) * w1.y + bfhi(nx.x) * w2.y;
            const float v2 = bflo(pv.y) * w0.z + bflo(cu.y) * w1.z + bflo(nx.y) * w2.z;
            const float v3 = bfhi(pv.y) * w0.w + bfhi(cu.y) * w1.w + bfhi(nx.y) * w2.w;
            o.x = pk2(fast_sigmoid(v0), fast_sigmoid(v1)); o.y = pk2(fast_sigmoid(v2), fast_sigmoid(v3));
        }
        *(u32x2*)(AG + (size_t)row * 256 + 4 * lane) = o;
        {
            const int vec = lane >> 2, pi = lane & 3;
            bf16_t* base = ur + (vec < 8 ? 2048 + vec * 64 : 2560 + (vec - 8) * 64) + (pi >> 1) * 32 + (pi & 1) * 8;
            const float pos = (float)((pi >> 1) ? (t & 63) : (t >> 6));
            const u32x4 z1 = *(const u32x4*)base, z2 = *(const u32x4*)(base + 16);
            float a1[8] = {bflo(z1.x), bfhi(z1.x), bflo(z1.y), bfhi(z1.y), bflo(z1.z), bfhi(z1.z), bflo(z1.w), bfhi(z1.w)};
            float a2[8] = {bflo(z2.x), bfhi(z2.x), bflo(z2.y), bfhi(z2.y), bflo(z2.z), bfhi(z2.z), bflo(z2.w), bfhi(z2.w)};
            float o1[8], o2[8];
#pragma unroll
            for (int j = 0; j < 8; ++j) {
                const float fi = (float)((pi & 1) * 8 + j);
                const float fr = __builtin_amdgcn_exp2f(-0.8304820237218406f * fi);
                float rev = pos * fr * 0.15915494309189535f; rev -= floorf(rev);
                const float sn = __builtin_amdgcn_sinf(rev), cs = __builtin_amdgcn_cosf(rev);
                o1[j] = a1[j] * cs - a2[j] * sn; o2[j] = a2[j] * cs + a1[j] * sn;
            }
            u32x4 w1, w2;
            w1.x = pk2(o1[0], o1[1]); w1.y = pk2(o1[2], o1[3]); w1.z = pk2(o1[4], o1[5]); w1.w = pk2(o1[6], o1[7]);
            w2.x = pk2(o2[0], o2[1]); w2.y = pk2(o2[2], o2[3]); w2.z = pk2(o2[4], o2[5]); w2.w = pk2(o2[6], o2[7]);
            *(u32x4*)base = w1; *(u32x4*)(base + 16) = w2;
        }
    }
}

constexpr int SC_W = 0, SC_KK = 8192, SC_BB = 16384, SC_KD = 24576, SC_R = 32768, SC_V = 40960, SC_KC = 49152, SC_TW = 57344, SC_TA = 57344 + 4608,
              SC_YS = 66560, SC_BON = 74752, SC_SHW = 75008, SC_RAW = 78848, SC_A = SC_RAW  ,
              SC_SF = 100608  , SC_SV = 116992  ,
              SC_SUB = 130304, SUB_BYTES = 15616  , SB_KRT = 0  , SB_BDT = 4608  ,
              SB_BH = 9216  , SB_MBK = 14336  , SB_G16 = 15360  ,
              SC_MM = SC_KC  , MM_BYTES = 3840, MM_MB1 = 0  , MM_MB2 = 1280  , MM_MBT = 2560  ;
static_assert(SC_SUB + 2 * SUB_BYTES <= 163072 && 2 * MM_BYTES <= 8192, "scan LDS map");
DI float sum16(float x) {
    x += dpp_f(x, 0); x += dpp_f(x, 1); x += dpp_f(x, 2);
    x += __builtin_bit_cast(float, __builtin_amdgcn_update_dpp(0, __builtin_bit_cast(int, x), 0x140, 0xF, 0xF, true));
    return x;
}
DI void scan_chunk_pos(int ch, int dir, int b, int& seg, int& c0, int& L, size_t& segrow) {
    if (ch < 8) { seg = 0; c0 = (dir ? 7 - ch : ch) * 32; } else { seg = 1; c0 = (dir ? 63 - (ch - 8) : ch - 8) * 32; }
    L = seg ? T : CT; segrow = seg ? (size_t)b * T : (size_t)ML + (size_t)b * CT;
}
DI void scan_issue_raw(const bf16_t* U, LAS unsigned char* lds, int chx, int dir, int b, int wave, const int (&pre)[3]) {
    int seg, c0, L; size_t segrow; scan_chunk_pos(chx, dir, b, seg, c0, L, segrow);
#pragma unroll
    for (int it = 0; it < 3; ++it) {
        if (pre[it] >= 0) {
            int p = c0 - 1 + (pre[it] & 255); p = p < 0 ? 0 : (p > L - 1 ? L - 1 : p);
            const bf16_t* gp = U + (segrow + p) * UP + (pre[it] >> 8);
            __builtin_amdgcn_global_load_lds((const unsigned*)gp, (LAS unsigned*)(lds + SC_RAW + (wave + 8 * it) * 1024), 16, 0, 0);
        }
    }
}
DI void scanA_item(LAS unsigned char* lds, int i, int chn, int c0, int L) {
                const int grp = chn >> 3, c8 = (chn & 7) * 8;
                const int p = c0 + i;
                const LAS unsigned char* rp = lds + SC_RAW + (i * 40 + chn) * 16;
                u32x4 pv = *(const LAS u32x4*)rp; const u32x4 cu = *(const LAS u32x4*)(rp + 640); u32x4 nx = *(const LAS u32x4*)(rp + 1280);
                if (p == 0) pv = (u32x4){0u, 0u, 0u, 0u};
                if (p == L - 1) nx = (u32x4){0u, 0u, 0u, 0u};
                const LAS float* sw = (const LAS float*)(lds + SC_SHW) + chn * 8;
                const f32x4 w0a = *(const LAS f32x4*)sw, w0b = *(const LAS f32x4*)(sw + 4);
                const f32x4 w1a = *(const LAS f32x4*)(sw + 320), w1b = *(const LAS f32x4*)(sw + 324);
                const f32x4 w2a = *(const LAS f32x4*)(sw + 640), w2b = *(const LAS f32x4*)(sw + 644);
                f32x4 va, vb;
                va.x = bflo(pv.x) * w0a.x + bflo(cu.x) * w1a.x + bflo(nx.x) * w2a.x;
                va.y = bfhi(pv.x) * w0a.y + bfhi(cu.x) * w1a.y + bfhi(nx.x) * w2a.y;
                va.z = bflo(pv.y) * w0a.z + bflo(cu.y) * w1a.z + bflo(nx.y) * w2a.z;
                va.w = bfhi(pv.y) * w0a.w + bfhi(cu.y) * w1a.w + bfhi(nx.y) * w2a.w;
                vb.x = bflo(pv.z) * w0b.x + bflo(cu.z) * w1b.x + bflo(nx.z) * w2b.x;
                vb.y = bfhi(pv.z) * w0b.y + bfhi(cu.z) * w1b.y + bfhi(nx.z) * w2b.y;
                vb.z = bflo(pv.w) * w0b.z + bflo(cu.w) * w1b.z + bflo(nx.w) * w2b.z;
                vb.w = bfhi(pv.w) * w0b.w + bfhi(cu.w) * w1b.w + bfhi(nx.w) * w2b.w;
                if (grp < 3) {
                    LAS float* dst = (LAS float*)(lds + (grp == 0 ? SC_R : (grp == 1 ? SC_KC : SC_V))) + i * 64 + c8;
                    *(LAS f32x4*)dst = va; *(LAS f32x4*)(dst + 4) = vb;
                } else {
                    if (grp == 3) {
#pragma unroll
                        for (int j = 0; j < 4; ++j) { va[j] = 1.f - 2.f * __builtin_amdgcn_rcpf(__builtin_amdgcn_exp2f(2.885390081777927f * va[j]) + 1.f);
                                                      vb[j] = 1.f - 2.f * __builtin_amdgcn_rcpf(__builtin_amdgcn_exp2f(2.885390081777927f * vb[j]) + 1.f); }
                    }
                    u32x4 w; w.x = pk2(va.x, va.y); w.y = pk2(va.z, va.w); w.z = pk2(vb.x, vb.y); w.w = pk2(vb.z, vb.w);
                    *(LAS u32x4*)(lds + (grp == 3 ? SC_TW : SC_TA) + (i * 72 + c8) * 2) = w;
                }
}
DI void scan_phase(const Args& a, LAS unsigned char* lds, int tid, int lane, int wave) {
    const bf16_t* U = (const bf16_t*)(a.ws + WS_U); bf16_t* Y = (bf16_t*)(a.ws + WS_Y); float* BON = (float*)(a.ws + WS_BON);
    const float* shw = a.in[11]; const float* w0p = a.in[12]; const float* w2p = a.in[13]; const float* a0p = a.in[14]; const float* a2p = a.in[15];
    const float* k_k = a.in[17]; const float* k_a = a.in[18]; const float* r_k = a.in[19];
    const int hh = lane >> 5, r32 = lane & 31;
    for (int item = blockIdx.x; item < 256; item += gridDim.x) {
        const int b = item >> 4, h = (item >> 1) & 7, dir = item & 1;
        int pre[3];
#pragma unroll
        for (int it = 0; it < 3; ++it) {
            const int j = wave + 8 * it, q = 64 * j + lane;
            if (j < 22 && q < 1360) { const int ts = q / 40, chn = q % 40, grp = chn >> 3, c8 = (chn & 7) * 8;
                pre[it] = ts | (((grp < 3 ? grp * 512 + h * 64 : (grp == 3 ? 1536 : 1664) + dir * 64) + c8) << 8); }
            else pre[it] = -1;
        }
        scan_issue_raw(U, lds, 0, dir, b, wave, pre);
        bf16x8 bfr[4];
        float bias0 = 0.f;
        {
            const int mat = wave & 1, nb = (wave >> 1) & 1;
            const float* Wl = (mat == 0 ? w2p : a2p) + (size_t)dir * 64 * 512 + h * 64;
#pragma unroll
            for (int ks = 0; ks < 4; ++ks) {
                float t8[8];
#pragma unroll
                for (int j = 0; j < 8; ++j) t8[j] = Wl[(size_t)(16 * ks + 8 * hh + j) * 512 + 32 * nb + r32];
                u32x4 w; w.x = pk2(t8[0], t8[1]); w.y = pk2(t8[2], t8[3]); w.z = pk2(t8[4], t8[5]); w.w = pk2(t8[6], t8[7]);
                bfr[ks] = __builtin_bit_cast(bf16x8, w);
            }
            bias0 = ((mat == 0 ? w0p : a0p) + dir * 512 + h * 64)[32 * nb + r32];
        }
        const int ci = tid >> 4, cq = tid & 15, ck4 = 4 * cq;
        const f32x4 kk4 = *(const f32x4*)(k_k + h * 64 + ck4), ka4 = *(const f32x4*)(k_a + h * 64 + ck4), rk4 = *(const f32x4*)(r_k + h * 64 + ck4);
        for (int idx = tid; idx < 960; idx += 512) { const int tap = idx / 320, cc = idx % 320, grp = cc >> 6;
            const int col = (grp < 3 ? grp * 512 + h * 64 : (grp == 3 ? 1536 : 1664) + dir * 64) + (cc & 63);
            *(LAS float*)(lds + SC_SHW + idx * 4) = shw[tap * 1920 + col]; }
        for (int idx = tid; idx < 4096; idx += 512) *(LAS float*)(lds + SC_SF + idx * 4) = 0.f;
        for (int idx = tid; idx < 13312 / 16; idx += 512) *(LAS u32x4*)(lds + SC_SV + idx * 16) = (u32x4){0u, 0u, 0u, 0u};
        asm volatile("s_waitcnt vmcnt(0)" ::: "memory");
        __syncthreads();
        for (int ch = 0; ch < 72; ++ch) {
            int seg, c0, L; size_t segrow; scan_chunk_pos(ch, dir, b, seg, c0, L, segrow);
#pragma unroll 1
            for (int item2 = tid; item2 < (ch == 0 ? 1280 : 768); item2 += 512) {
                int i, chn;
                if (item2 < 768) { i = item2 / 24; chn = item2 - 24 * i; } else { const int j = (item2 - 768) & 255; i = j >> 3; chn = (item2 < 1024 ? 24 : 32) + (j & 7); }
                scanA_item(lds, i, chn, c0, L);
            }
            __syncthreads();
            {
                const int mat = wave & 1, nb = (wave >> 1) & 1, half = wave >> 2;
                const LAS unsigned char* X = lds + (mat == 0 ? SC_TW : SC_TA);
                f32x16 acc0;
#pragma unroll
                for (int i = 0; i < 16; ++i) acc0[i] = 0.f;
#pragma unroll
                for (int ks = 0; ks < 4; ++ks) {
                    const bf16x8 af = *(const LAS bf16x8*)(X + (r32 * 72 + 16 * ks + 8 * hh) * 2);
                    acc0 = __builtin_amdgcn_mfma_f32_32x32x16_bf16(af, bfr[ks], acc0, 0, 0, 0);
                }
                LAS float* dst = (LAS float*)(lds + (mat == 0 ? SC_W : SC_A)) + 32 * nb + r32;
#pragma unroll
                for (int i8 = 0; i8 < 8; ++i8) {
                    const float av = half ? acc0[8 + i8] : acc0[i8];
                    float s0 = fast_sigmoid(av + bias0);
                    if (mat == 0) s0 = __builtin_amdgcn_exp2f(-0.8750612633917001f * s0);
                    dst[(crow(i8, hh) + 16 * half) * 64] = s0;
                }
            }
            __syncthreads();
            {
                const f32x4 kc = *(const LAS f32x4*)(lds + SC_KC + (ci * 64 + ck4) * 4);
                const f32x4 kkr = kc * kk4;
                float ss = (kkr.x * kkr.x + kkr.y * kkr.y) + (kkr.z * kkr.z + kkr.w * kkr.w);
                ss = sum16(ss);
                const f32x4 kk = kkr * rsqrtf(ss + 1e-12f);
                const f32x4 av = *(const LAS f32x4*)(lds + SC_A + (ci * 64 + ck4) * 4);
                const f32x4 bb = kk * av;
                const f32x4 kd = kc * (1.f + (av - 1.f) * ka4);
                const f32x4 rv = *(const LAS f32x4*)(lds + SC_R + (ci * 64 + ck4) * 4);
                const f32x4 pb = rv * kd * rk4;
                const float bon = sum16((pb.x + pb.y) + (pb.z + pb.w));
                *(LAS f32x4*)(lds + SC_KK + (ci * 64 + ck4) * 4) = kk;
                *(LAS f32x4*)(lds + SC_BB + (ci * 64 + ck4) * 4) = bb;
                *(LAS f32x4*)(lds + SC_KD + (ci * 64 + ck4) * 4) = kd;
                if (cq == 0) *(LAS float*)(lds + SC_BON + ci * 4) = bon;
            }
            __syncthreads();
            if (ch + 1 < 72) scan_issue_raw(U, lds, ch + 1, dir, b, wave, pre);
            {
                int tido = tid; asm volatile("" : "+v"(tido));
                const int ln = tido & 63, l15 = tido & 15, g4 = (tido >> 4) & 3;
                {
                    const int sub = wave >> 2, th = wave & 3, k = ln;
                    LAS unsigned char* sb = lds + SC_SUB + sub * SUB_BYTES;
                    float pg[17]; pg[0] = 1.f;
#pragma unroll
                    for (int st = 0; st < 16; ++st) {
                        const int tok = dir ? 31 - (16 * sub + st) : 16 * sub + st;
                        pg[st + 1] = pg[st] * *(const LAS float*)(lds + SC_W + (tok * 64 + k) * 4);
                    }
                    const float g = pg[16];
                    if (th == 0) *(LAS float*)(sb + SB_G16 + k * 4) = g;
#define SC_D_STEP(TT) do { const int t = (TT); const float gp = pg[TT], gc = pg[(TT) + 1]; \
                        const int tok = dir ? 31 - (16 * sub + t) : 16 * sub + t; \
                        const float kkv = *(const LAS float*)(lds + SC_KK + (tok * 64 + k) * 4), bbv = *(const LAS float*)(lds + SC_BB + (tok * 64 + k) * 4); \
                        const float kdv = *(const LAS float*)(lds + SC_KD + (tok * 64 + k) * 4), rv = *(const LAS float*)(lds + SC_R + (tok * 64 + k) * 4); \
                        const float ig = __builtin_amdgcn_rcpf(gc), bt = bbv * ig, dt = kdv * ig; \
                        *(LAS bf16_t*)(sb + SB_KRT + (t * 72 + k) * 2) = (bf16_t)(pk2(kkv * gp, 0.f) & 0xffffu); \
                        *(LAS bf16_t*)(sb + SB_KRT + ((16 + t) * 72 + k) * 2) = (bf16_t)(pk2(rv * gc, 0.f) & 0xffffu); \
                        *(LAS bf16_t*)(sb + SB_BDT + (t * 72 + k) * 2) = (bf16_t)(pk2(bt, 0.f) & 0xffffu); \
                        *(LAS bf16_t*)(sb + SB_BDT + ((16 + t) * 72 + k) * 2) = (bf16_t)(pk2(dt, 0.f) & 0xffffu); \
                        *(LAS bf16_t*)(sb + SB_BH + (k * 40 + 8 * (t >> 2) + (t & 3)) * 2) = (bf16_t)(pk2(bt * g, 0.f) & 0xffffu);         \
                        *(LAS bf16_t*)(sb + SB_BH + (k * 40 + 8 * (t >> 2) + 4 + (t & 3)) * 2) = (bf16_t)(pk2(dt * g, 0.f) & 0xffffu);     } while (0)
                    if (th == 0) { SC_D_STEP(0); SC_D_STEP(1); SC_D_STEP(2); SC_D_STEP(3); }
                    else if (th == 1) { SC_D_STEP(4); SC_D_STEP(5); SC_D_STEP(6); SC_D_STEP(7); }
                    else if (th == 2) { SC_D_STEP(8); SC_D_STEP(9); SC_D_STEP(10); SC_D_STEP(11); }
                    else { SC_D_STEP(12); SC_D_STEP(13); SC_D_STEP(14); SC_D_STEP(15); }
#undef SC_D_STEP
                }
                __syncthreads();
                {
                    const int sub = wave >> 2, wq = wave & 3, jb = wq >> 1, tb = wq & 1;
                    const LAS unsigned char* sb = lds + SC_SUB + sub * SUB_BYTES; LAS unsigned char* mm = lds + SC_MM + sub * MM_BYTES;
                    f32x4 acc = {0.f, 0.f, 0.f, 0.f};
#pragma unroll
                    for (int kb = 0; kb < 2; ++kb) {
                        const bf16x8 av = *(const LAS bf16x8*)(sb + SB_BDT + ((16 * jb + l15) * 72 + 32 * kb + 8 * g4) * 2);
                        const bf16x8 bv = *(const LAS bf16x8*)(sb + SB_KRT + ((16 * tb + l15) * 72 + 32 * kb + 8 * g4) * 2);
                        acc = __builtin_amdgcn_mfma_f32_16x16x32_bf16(av, bv, acc, 0, 0, 0);
                    }
                    const int t = l15;
#pragma unroll
                    for (int r = 0; r < 4; ++r) {
                        const int j = 4 * g4 + r;
                        const float mv = (tb == 0 ? (j < t) : (j <= t)) ? acc[r] : 0.f;
                        if (wq == 0) *(LAS float*)((LAS unsigned char*)sb + SB_MBK + (j * 16 + t) * 4) = mv;
                        else if (wq == 2) { *(LAS bf16_t*)(mm + MM_MB1 + (t * 40 + j) * 2) = (bf16_t)(pk2(mv, 0.f) & 0xffffu); *(LAS bf16_t*)(mm + MM_MB1 + (t * 40 + 16 + j) * 2) = 0; }
                        else if (wq == 1) *(LAS bf16_t*)(mm + MM_MB2 + (t * 40 + 8 * g4 + r) * 2) = (bf16_t)(pk2(mv, 0.f) & 0xffffu);
                        else *(LAS bf16_t*)(mm + MM_MB2 + (t * 40 + 8 * g4 + 4 + r) * 2) = (bf16_t)(pk2(mv, 0.f) & 0xffffu);
                    }
                }
                if ((wave & 3) == 0) {
                    const int sub = wave >> 2;
                    const LAS unsigned char* sb = lds + SC_SUB + sub * SUB_BYTES; LAS unsigned char* mm = lds + SC_MM + sub * MM_BYTES;
                    float acc[16];
#pragma unroll
                    for (int u = 0; u < 16; ++u) acc[u] = 0.f;
#pragma unroll
                    for (int t = 0; t < 16; ++t) {
                        const float sv = ((l15 == t) ? 1.f : 0.f) - acc[t];
                        if (ln < 16) { *(LAS bf16_t*)(mm + MM_MBT + (t * 40 + 8 * (ln >> 2) + (ln & 3)) * 2) = (bf16_t)(pk2(sv, 0.f) & 0xffffu);
                                       *(LAS bf16_t*)(mm + MM_MBT + (t * 40 + 8 * (ln >> 2) + 4 + (ln & 3)) * 2) = 0; }
#pragma unroll
                        for (int uq = 0; uq < 4; ++uq) {
                            if (4 * uq + 3 > t) {
                                const f32x4 m4 = *(const LAS f32x4*)(sb + SB_MBK + (t * 16 + 4 * uq) * 4);
#pragma unroll
                                for (int uu = 0; uu < 4; ++uu) if (4 * uq + uu > t) acc[4 * uq + uu] += sv * m4[uu];
                            }
                        }
                    }
                }
                asm volatile("s_waitcnt vmcnt(0)" ::: "memory");
                __syncthreads();
                if (wave >= 4) {
                    if (ch + 1 < 72) {
                        int segn, c0n, Ln; size_t segrown; scan_chunk_pos(ch + 1, dir, b, segn, c0n, Ln, segrown);
                        const int j = tid - 256;
                        scanA_item(lds, j >> 3, 24 + (j & 7), c0n, Ln);
                        scanA_item(lds, j >> 3, 32 + (j & 7), c0n, Ln);
                    }
                } else {
                    const int v = 16 * wave + l15;
                    const LAS unsigned char* svrow = lds + SC_SV + v * 208;
#pragma unroll 1
                    for (int sub = 0; sub < 2; ++sub) {
                        const LAS unsigned char* sb = lds + SC_SUB + sub * SUB_BYTES; const LAS unsigned char* mm = lds + SC_MM + sub * MM_BYTES;
                        u32x2 vc;
                        {
                            float vv[4];
#pragma unroll
                            for (int r = 0; r < 4; ++r) { const int tok = dir ? 31 - (16 * sub + 4 * g4 + r) : 16 * sub + 4 * g4 + r; vv[r] = *(const LAS float*)(lds + SC_V + (tok * 64 + v) * 4); }
                            vc.x = pk2(vv[0], vv[1]); vc.y = pk2(vv[2], vv[3]);
                            *(LAS u32x2*)((LAS unsigned char*)svrow + 128 + 8 * g4) = vc;
                        }
                        f32x4 acc = {0.f, 0.f, 0.f, 0.f};
#pragma unroll
                        for (int kb = 0; kb < 2; ++kb)
                            acc = __builtin_amdgcn_mfma_f32_16x16x32_bf16(*(const LAS bf16x8*)(sb + SB_KRT + (l15 * 72 + 32 * kb + 8 * g4) * 2), *(const LAS bf16x8*)(svrow + 64 * kb + 16 * g4), acc, 0, 0, 0);
                        acc = __builtin_amdgcn_mfma_f32_16x16x32_bf16(*(const LAS bf16x8*)(mm + MM_MB1 + (l15 * 40 + 8 * g4) * 2), *(const LAS bf16x8*)(svrow + 128 + 16 * g4), acc, 0, 0, 0);
                        u32x4 rb; rb.x = pk2(acc[0], acc[1]); rb.y = pk2(acc[2], acc[3]); rb.z = 0u; rb.w = 0u;
                        const f32x4 sa = __builtin_amdgcn_mfma_f32_16x16x32_bf16(*(const LAS bf16x8*)(mm + MM_MBT + (l15 * 40 + 8 * g4) * 2), __builtin_bit_cast(bf16x8, rb), (f32x4){0.f, 0.f, 0.f, 0.f}, 0, 0, 0);
                        u32x4 sb4; sb4.x = pk2(-sa[0], -sa[1]); sb4.y = pk2(-sa[2], -sa[3]); sb4.z = vc.x; sb4.w = vc.y;
                        const bf16x8 bop = __builtin_bit_cast(bf16x8, sb4);
                        f32x4 ya = {0.f, 0.f, 0.f, 0.f};
#pragma unroll
                        for (int kb = 0; kb < 2; ++kb)
                            ya = __builtin_amdgcn_mfma_f32_16x16x32_bf16(*(const LAS bf16x8*)(sb + SB_KRT + ((16 + l15) * 72 + 32 * kb + 8 * g4) * 2), *(const LAS bf16x8*)(svrow + 64 * kb + 16 * g4), ya, 0, 0, 0);
                        ya = __builtin_amdgcn_mfma_f32_16x16x32_bf16(*(const LAS bf16x8*)(mm + MM_MB2 + (l15 * 40 + 8 * g4) * 2), bop, ya, 0, 0, 0);
#pragma unroll
                        for (int r = 0; r < 4; ++r) { const int tok = dir ? 31 - (16 * sub + 4 * g4 + r) : 16 * sub + 4 * g4 + r; *(LAS float*)(lds + SC_YS + (tok * 64 + v) * 4) = ya[r]; }
#pragma unroll
                        for (int kt = 0; kt < 4; ++kt) {
                            const f32x4 dS = __builtin_amdgcn_mfma_f32_16x16x32_bf16(*(const LAS bf16x8*)(sb + SB_BH + ((16 * kt + l15) * 40 + 8 * g4) * 2), bop, (f32x4){0.f, 0.f, 0.f, 0.f}, 0, 0, 0);
                            const int k = 16 * kt + 4 * g4;
                            const f32x4 g16 = *(const LAS f32x4*)(sb + SB_G16 + k * 4);
                            const f32x4 sn = *(const LAS f32x4*)(lds + SC_SF + (v * 64 + k) * 4) * g16 + dS;
                            *(LAS f32x4*)(lds + SC_SF + (v * 64 + k) * 4) = sn;
                            u32x2 w; w.x = pk2(sn[0], sn[1]); w.y = pk2(sn[2], sn[3]);
                            *(LAS u32x2*)((LAS unsigned char*)svrow + k * 2) = w;
                        }
                    }
                }
            }
            asm volatile("s_waitcnt vmcnt(0)" ::: "memory");
            __syncthreads();
            if (seg) {
                const f32x4 yv = *(const LAS f32x4*)(lds + SC_YS + (ci * 64 + ck4) * 4);
                u32x2 o; o.x = pk2(yv.x, yv.y); o.y = pk2(yv.z, yv.w);
                *(u32x2*)(Y + ((size_t)dir * ML + (size_t)b * T + c0 + ci) * 512 + h * 64 + ck4) = o;
                if (tid < 32) BON[((size_t)dir * ML + (size_t)b * T + c0 + tid) * 8 + h] = *(const LAS float*)(lds + SC_BON + tid * 4);
            }
        }
        __syncthreads();
    }
}

DI s16x4 tr_read(const LAS unsigned char* p) { return __builtin_bit_cast(s16x4, __builtin_amdgcn_ds_read_tr16_b64_v4i16((LAS v4i16_t*)p)); }
DI void attn_phase(const Args& a, LAS unsigned char* lds, int tid, int lane, int wave) {
    const bf16_t* U = (const bf16_t*)(a.ws + WS_U); bf16_t* O = (bf16_t*)(a.ws + WS_O);
    const float* dl = a.in[22]; const float* subg = a.in[23];
    const float lam = __expf(wave_sum(dl[lane] * dl[64 + lane])) - __expf(wave_sum(dl[128 + lane] * dl[192 + lane])) + 0.2f;
    const int c = wave & 1, qblk = wave >> 1, hh = lane >> 5, r32 = lane & 31;
    constexpr int KP = 272, VP = 320, KBYTES = 64 * KP, STG = KBYTES + 64 * VP;
    constexpr float SCL = 0.125f * 1.4426950408889634f;
    const int i16 = lane & 15, q_ = i16 >> 2, p_ = i16 & 3, g_ = lane >> 4;
    for (int u0 = blockIdx.x; u0 < 1024; u0 += gridDim.x) {
        int u = u0;
        if (gridDim.x == 256) { const int j = u0 & 255, i = u0 >> 8; u = (j & 7) * 128 + i * 32 + (j >> 3); }
        const int b = u >> 6, h = (u >> 4) & 3, qb = u & 15;
        const size_t qrow = (size_t)b * T + qb * 128 + qblk * 32 + r32;
        bf16x8 qf[4];
#pragma unroll
        for (int ks = 0; ks < 4; ++ks) qf[ks] = *(const bf16x8*)(U + qrow * UP + 2048 + h * 128 + c * 64 + 16 * ks + 8 * hh);
        f32x16 o[4];
#pragma unroll
        for (int eb = 0; eb < 4; ++eb)
#pragma unroll
            for (int i = 0; i < 16; ++i) o[eb][i] = 0.f;
        float m_used = -1e30f, l = 0.f;
        const int skey0 = tid >> 4, sch = tid & 15;
        u32x4 rk0, rk1, rv0, rv1;
        const bf16_t* kp = U + ((size_t)ML + (size_t)b * CT + skey0) * UP + h * 128 + sch * 8;
        const bf16_t* const kp_lat = U + ((size_t)b * T + skey0) * UP + h * 128 + sch * 8;
#define ATT_LOAD(tt) do { \
            rk0 = *(const u32x4*)(kp + 2560); rv0 = *(const u32x4*)(kp + 3072); \
            rk1 = *(const u32x4*)(kp + 32 * UP + 2560); rv1 = *(const u32x4*)(kp + 32 * UP + 3072); \
            kp = ((tt) == 3) ? kp_lat : kp + 64 * UP; } while (0)
#define ATT_STORE(buf) do { \
            LAS unsigned char* kb_ = lds + (buf) * STG; LAS unsigned char* vb_ = kb_ + KBYTES; \
            *(LAS u32x4*)(kb_ + skey0 * KP + sch * 16) = rk0; *(LAS u32x4*)(kb_ + (skey0 + 32) * KP + sch * 16) = rk1; \
            *(LAS u32x4*)(vb_ + skey0 * VP + sch * 16) = rv0; *(LAS u32x4*)(vb_ + (skey0 + 32) * VP + sch * 16) = rv1; } while (0)
        ATT_LOAD(0); ATT_STORE(0);
        __syncthreads();
        for (int t = 0; t < 36; ++t) {
            if (t + 1 < 36) ATT_LOAD(t + 1);
            const LAS unsigned char* Kt = lds + (t & 1) * STG; const LAS unsigned char* Vt = Kt + KBYTES;
            f32x16 s0, s1;
#pragma unroll
            for (int i = 0; i < 16; ++i) { s0[i] = 0.f; s1[i] = 0.f; }
#pragma unroll
            for (int ks = 0; ks < 4; ++ks) {
                const bf16x8 k0 = *(const LAS bf16x8*)(Kt + r32 * KP + (c * 64 + 16 * ks + 8 * hh) * 2);
                const bf16x8 k1 = *(const LAS bf16x8*)(Kt + (32 + r32) * KP + (c * 64 + 16 * ks + 8 * hh) * 2);
                s0 = __builtin_amdgcn_mfma_f32_32x32x16_bf16(k0, qf[ks], s0, 0, 0, 0);
                s1 = __builtin_amdgcn_mfma_f32_32x32x16_bf16(k1, qf[ks], s1, 0, 0, 0);
            }
            float tmax = fmaxf(s0[0], s1[0]), tmax2 = fmaxf(s0[1], s1[1]);
#pragma unroll
            for (int i = 2; i < 16; i += 2) { tmax = max3_s(tmax, s0[i], s1[i]); tmax2 = max3_s(tmax2, s0[i + 1], s1[i + 1]); }
            tmax = fmaxf(tmax, tmax2);
            tmax = fmaxf(tmax, __shfl_xor(tmax, 32));
            const float tm = tmax * SCL;
            if (__any(tm > m_used + 8.f)) {
                const float mn = fmaxf(m_used, tm);
                const float al = __builtin_amdgcn_exp2f(m_used - mn);
#pragma unroll
                for (int eb = 0; eb < 4; ++eb) o[eb] = o[eb] * al;
                l *= al; m_used = mn;
            }
            bf16x8 pf[2][2];
            {
                float p0[16], p1[16];
#pragma unroll
                for (int i = 0; i < 16; ++i) { p0[i] = __builtin_amdgcn_exp2f(__builtin_fmaf(s0[i], SCL, -m_used)); p1[i] = __builtin_amdgcn_exp2f(__builtin_fmaf(s1[i], SCL, -m_used)); l += p0[i] + p1[i]; }
#pragma unroll
                for (int s = 0; s < 2; ++s) {
                    u32x4 w0, w1;
                    w0.x = pk2(p0[8 * s + 0], p0[8 * s + 1]); w0.y = pk2(p0[8 * s + 2], p0[8 * s + 3]); w0.z = pk2(p0[8 * s + 4], p0[8 * s + 5]); w0.w = pk2(p0[8 * s + 6], p0[8 * s + 7]);
                    w1.x = pk2(p1[8 * s + 0], p1[8 * s + 1]); w1.y = pk2(p1[8 * s + 2], p1[8 * s + 3]); w1.z = pk2(p1[8 * s + 4], p1[8 * s + 5]); w1.w = pk2(p1[8 * s + 6], p1[8 * s + 7]);
                    pf[0][s] = __builtin_bit_cast(bf16x8, w0); pf[1][s] = __builtin_bit_cast(bf16x8, w1);
                }
            }
#pragma unroll
            for (int kb = 0; kb < 2; ++kb)
#pragma unroll
                for (int s = 0; s < 2; ++s)
#pragma unroll
                    for (int eb = 0; eb < 4; ++eb) {
                        const LAS unsigned char* vb = Vt + (32 * kb + 16 * s + 4 * hh + q_) * VP + (32 * eb + 16 * (g_ & 1) + 4 * p_) * 2;
                        const s16x4 lo = tr_read(vb), hi = tr_read(vb + 8 * VP);
                        const bf16x8 vf = {lo[0], lo[1], lo[2], lo[3], hi[0], hi[1], hi[2], hi[3]};
                        o[eb] = __builtin_amdgcn_mfma_f32_32x32x16_bf16(vf, pf[kb][s], o[eb], 0, 0, 0);
                    }
            if (t + 1 < 36) ATT_STORE((t + 1) & 1);
            __syncthreads();
        }
#undef ATT_LOAD
#undef ATT_STORE
        l += __shfl_xor(l, 32);
        const float inv = 1.f / l;
        LAS float* XO = (LAS float*)lds + qblk * 4096;
        if (c == 1) {
            const float sc = inv * lam;
#pragma unroll
            for (int eb = 0; eb < 4; ++eb)
#pragma unroll
                for (int i = 0; i < 16; ++i) XO[(32 * eb + crow(i, hh)) * 32 + r32] = o[eb][i] * sc;
        }
        __syncthreads();
        if (c == 0) {
            float ss = 0.f;
#pragma unroll
            for (int eb = 0; eb < 4; ++eb)
#pragma unroll
                for (int i = 0; i < 16; ++i) { const float vv = o[eb][i] * inv - XO[(32 * eb + crow(i, hh)) * 32 + r32]; o[eb][i] = vv; ss += vv * vv; }
            ss += __shfl_xor(ss, 32);
            const float rstd = rsqrtf(ss * (1.f / 128.f) + EPS) * 0.8f;
#pragma unroll
            for (int eb = 0; eb < 4; ++eb)
#pragma unroll
                for (int g4 = 0; g4 < 4; ++g4) {
                    const int e0 = 32 * eb + 8 * g4 + 4 * hh;
                    const f32x4 sg = *(const f32x4*)(subg + e0);
                    u32x2 w; w.x = pk2(o[eb][4 * g4 + 0] * rstd * sg.x, o[eb][4 * g4 + 1] * rstd * sg.y); w.y = pk2(o[eb][4 * g4 + 2] * rstd * sg.z, o[eb][4 * g4 + 3] * rstd * sg.w);
                    *(u32x2*)(O + qrow * 512 + h * 128 + e0) = w;
                }
        }
        __syncthreads();
    }
}

DI void readout_phase(const Args& a, int lane, int wave) {
    const bf16_t* U = (const bf16_t*)(a.ws + WS_U); bf16_t* Y = (bf16_t*)(a.ws + WS_Y); const float* BON = (const float*)(a.ws + WS_BON); const bf16_t* Gb = (const bf16_t*)(a.ws + WS_G);
    const float* shw = a.in[11]; const float* lng = a.in[20]; const float* lnb = a.in[21];
    const int gw = blockIdx.x * 8 + wave, NGW = gridDim.x * 8;
    const int c8 = 8 * lane, head = lane >> 3;
    int r0, r1; wave_rows(ML, gw, NGW, r0, r1);
    if (r0 >= r1) return;
    const float* sw = shw + 1024 + c8;
    const f32x4 w0a = *(const f32x4*)sw, w0b = *(const f32x4*)(sw + 4), w1a = *(const f32x4*)(sw + 1920), w1b = *(const f32x4*)(sw + 1924), w2a = *(const f32x4*)(sw + 3840), w2b = *(const f32x4*)(sw + 3844);
    const f32x4 lga = *(const f32x4*)(lng + c8), lgb = *(const f32x4*)(lng + c8 + 4), lba = *(const f32x4*)(lnb + c8), lbb = *(const f32x4*)(lnb + c8 + 4);
    const float lg[8] = {lga.x, lga.y, lga.z, lga.w, lgb.x, lgb.y, lgb.z, lgb.w}, lb[8] = {lba.x, lba.y, lba.z, lba.w, lbb.x, lbb.y, lbb.z, lbb.w};
    const u32x4 z4 = {0u, 0u, 0u, 0u};
    const bf16_t* ub = U + 1024 + c8;
    u32x4 pv = (r0 > 0) ? *(const u32x4*)(ub + (size_t)(r0 - 1) * UP) : z4;
    u32x4 cu = *(const u32x4*)(ub + (size_t)r0 * UP);
    u32x4 nx = (r0 + 1 < ML) ? *(const u32x4*)(ub + (size_t)(r0 + 1) * UP) : z4;
    u32x4 yf = *(const u32x4*)(Y + (size_t)r0 * 512 + c8), yb = *(const u32x4*)(Y + ((size_t)ML + r0) * 512 + c8), gr = *(const u32x4*)(Gb + (size_t)r0 * 512 + c8);
    float bonus = BON[(size_t)r0 * 8 + head] + BON[((size_t)ML + r0) * 8 + head];
    for (int row = r0; row < r1; ++row) {
        u32x4 nyf = z4, nyb = z4, ngr = z4, nnx = z4; float nbonus = 0.f;
        if (row + 1 < r1) {
            const int rn = row + 1;
            nyf = *(const u32x4*)(Y + (size_t)rn * 512 + c8); nyb = *(const u32x4*)(Y + ((size_t)ML + rn) * 512 + c8); ngr = *(const u32x4*)(Gb + (size_t)rn * 512 + c8);
            nbonus = BON[(size_t)rn * 8 + head] + BON[((size_t)ML + rn) * 8 + head];
            if (rn + 1 < ML) nnx = *(const u32x4*)(ub + (size_t)(rn + 1) * UP);
        }
        float y[8] = {bflo(yf.x) + bflo(yb.x), bfhi(yf.x) + bfhi(yb.x), bflo(yf.y) + bflo(yb.y), bfhi(yf.y) + bfhi(yb.y),
                      bflo(yf.z) + bflo(yb.z), bfhi(yf.z) + bfhi(yb.z), bflo(yf.w) + bflo(yb.w), bfhi(yf.w) + bfhi(yb.w)};
        float sm = 0.f;
#pragma unroll
        for (int j = 0; j < 8; ++j) sm += y[j];
        const float mu = sum8(sm) * (1.f / 64.f);
        float q = 0.f;
#pragma unroll
        for (int j = 0; j < 8; ++j) { y[j] -= mu; q += y[j] * y[j]; }
        const float rstd = rsqrtf(sum8(q) * (1.f / 64.f) + 64e-5f);
        const bool first = (row & (T - 1)) == 0, last = (row & (T - 1)) == T - 1;
        const u32x4 pvv = first ? z4 : pv, nxv = last ? z4 : nx;
        float vc[8];
        vc[0] = bflo(pvv.x) * w0a.x + bflo(cu.x) * w1a.x + bflo(nxv.x) * w2a.x;
        vc[1] = bfhi(pvv.x) * w0a.y + bfhi(cu.x) * w1a.y + bfhi(nxv.x) * w2a.y;
        vc[2] = bflo(pvv.y) * w0a.z + bflo(cu.y) * w1a.z + bflo(nxv.y) * w2a.z;
        vc[3] = bfhi(pvv.y) * w0a.w + bfhi(cu.y) * w1a.w + bfhi(nxv.y) * w2a.w;
        vc[4] = bflo(pvv.z) * w0b.x + bflo(cu.z) * w1b.x + bflo(nxv.z) * w2b.x;
        vc[5] = bfhi(pvv.z) * w0b.y + bfhi(cu.z) * w1b.y + bfhi(nxv.z) * w2b.y;
        vc[6] = bflo(pvv.w) * w0b.z + bflo(cu.w) * w1b.z + bflo(nxv.w) * w2b.z;
        vc[7] = bfhi(pvv.w) * w0b.w + bfhi(cu.w) * w1b.w + bfhi(nxv.w) * w2b.w;
        const float gv[8] = {bflo(gr.x), bfhi(gr.x), bflo(gr.y), bfhi(gr.y), bflo(gr.z), bfhi(gr.z), bflo(gr.w), bfhi(gr.w)};
        float ov[8];
#pragma unroll
        for (int j = 0; j < 8; ++j) ov[j] = (y[j] * rstd * lg[j] + lb[j] + bonus * vc[j]) * gv[j];
        u32x4 w; w.x = pk2(ov[0], ov[1]); w.y = pk2(ov[2], ov[3]); w.z = pk2(ov[4], ov[5]); w.w = pk2(ov[6], ov[7]);
        *(u32x4*)(Y + (size_t)row * 512 + c8) = w;
        pv = cu; cu = nx; nx = nnx; yf = nyf; yb = nyb; gr = ngr; bonus = nbonus;
    }
}

#define XB_TMO      128
#define XB_XCNT(j)  (256  + 64 * (j))
#define XB_XSUB(j)  (1280 + 64 * (j))
#define XB_XGEN(j)  (2304 + 64 * (j))
#define XB_TOP      3328
#define XB_TOPGEN   3392
#define XCD_BAR_WORDS 3456
#define XB_SPIN_CAP (1u << 18)

__device__ __forceinline__ unsigned xb_ld(unsigned* p)              { return __hip_atomic_load(p, __ATOMIC_RELAXED, __HIP_MEMORY_SCOPE_AGENT); }
__device__ __forceinline__ unsigned xb_add(unsigned* p, unsigned v) { return __hip_atomic_fetch_add(p, v, __ATOMIC_RELAXED, __HIP_MEMORY_SCOPE_AGENT); }
__device__ __forceinline__ unsigned xb_xcc_id() { return (unsigned)__builtin_amdgcn_s_getreg((3 << 11) | 20) & 0xFu; }
#define XB_SPIN(cond, bar) do { unsigned _sp = 0; while (cond) { __builtin_amdgcn_s_sleep(1); \
    if ((++_sp & 255u) == 0u) { if (xb_ld(&(bar)[XB_TMO])) break; if (_sp > XB_SPIN_CAP) { atomicAdd(&(bar)[XB_TMO], 1u); break; } } } } while (0)

struct XcdBarrier {
    unsigned* bar; unsigned x;
    volatile LAS unsigned* st;
};

__device__ __forceinline__ XcdBarrier xcd_barrier_post(unsigned* bar, volatile LAS unsigned* st) {
    XcdBarrier b; b.bar = bar; b.x = xb_xcc_id(); b.st = st;
    if (threadIdx.x == 0) (void)xb_add(&bar[XB_XCNT(b.x)], 1u);
    return b;
}
__device__ __forceinline__ void xcd_barrier_complete(unsigned* bar, unsigned x, unsigned& nloc, unsigned& nx) {
    const unsigned G = gridDim.x * gridDim.y * gridDim.z;
    unsigned sum, cnt, mine, sp = 0u;
    for (;;) {
        sum = 0u; cnt = 0u; mine = 0u;
#pragma unroll
        for (unsigned j = 0; j < 16; ++j) { const unsigned c = xb_ld(&bar[XB_XCNT(j)]); sum += c; cnt += (c > 0u) ? 1u : 0u; mine = (j == x) ? c : mine; }
        if (sum == G) break;
        __builtin_amdgcn_s_sleep(1);
        if ((++sp & 255u) == 0u) { if (xb_ld(&bar[XB_TMO])) break; if (sp > XB_SPIN_CAP) { atomicAdd(&bar[XB_TMO], 1u); break; } }
    }
    nloc = mine > 0u ? mine : 1u; nx = cnt > 0u ? cnt : 1u;
}

__device__ __forceinline__ void xcd_barrier(const XcdBarrier& b) {
    asm volatile("s_waitcnt vmcnt(0)" ::: "memory");
    __syncthreads();
    if (threadIdx.x == 0) {
        unsigned* bar = b.bar;
        __builtin_amdgcn_s_waitcnt(0);
        unsigned nloc = b.st[0], nx = b.st[1];
        if (nloc == 0u) { xcd_barrier_complete(bar, b.x, nloc, nx); b.st[0] = nloc; b.st[1] = nx; }
        const unsigned old = xb_add(&bar[XB_XSUB(b.x)], 1u);
        const unsigned gen = old / nloc;
        if (old + 1u == (gen + 1u) * nloc) {
            __builtin_amdgcn_fence(__ATOMIC_RELEASE, "agent");
            asm volatile("s_waitcnt vmcnt(0)" ::: "memory");
            const unsigned og = xb_add(&bar[XB_TOP], 1u);
            const unsigned tg = og / nx;
            if (og + 1u == (tg + 1u) * nx) xb_add(&bar[XB_TOPGEN], 1u);
            else XB_SPIN(xb_ld(&bar[XB_TOPGEN]) == tg, bar);
            __builtin_amdgcn_fence(__ATOMIC_ACQUIRE, "agent");
            xb_add(&bar[XB_XGEN(b.x)], 1u);
            asm volatile("s_waitcnt vmcnt(0)" ::: "memory");
        } else {
            XB_SPIN(xb_ld(&bar[XB_XGEN(b.x)]) == gen, bar);
            __builtin_amdgcn_fence(__ATOMIC_ACQUIRE, "agent");
            asm volatile("s_waitcnt vmcnt(0)" ::: "memory");
        }
    }
    __syncthreads();
}

__global__ void __launch_bounds__(512, 2) mk_fwd(Args a) {
    extern __shared__ __attribute__((aligned(16))) unsigned char lds_raw[];
    cg::grid_group grid = cg::this_grid();
    LAS unsigned char* lds = (LAS unsigned char*)lds_raw;
    const int tid = threadIdx.x, lane = tid & 63, wave = __builtin_amdgcn_readfirstlane(tid >> 6);
    unsigned char* ws = a.ws;
    const int gw = blockIdx.x * 8 + wave, NGW = gridDim.x * 8;
    const float* MOD = (const float*)(ws + WS_MOD);
    const float* preg = a.in[6]; const float* postg = a.in[7];
    bf16_t* H = (bf16_t*)(ws + WS_H);
    const int lo = a.ph_lo & 0xff, hi = a.ph_hi;
    if (tid < 2) *(volatile LAS unsigned*)(lds + LDS_BARST + 4 * tid) = 0u;
    __syncthreads();
    const XcdBarrier xbar = xcd_barrier_post((unsigned*)(ws + WS_BAR), (volatile LAS unsigned*)(lds + LDS_BARST));
#define IN(k) (lo <= (k) && (k) < hi)
#define SEAM(k) do { if (IN(k) && IN((k) + 1)) xcd_barrier(xbar); } while (0)
    if (hi > 4096) grid.sync();

#ifndef NO_P0
    if (IN(0)) p0_phase(a, lds, tid, lane, wave);
#endif
    SEAM(0);
#pragma unroll 1
    for (int rsy = 0; rsy < ((a.ph_lo >> 16) & 63); ++rsy) xcd_barrier(xbar);
    if (IN(1)) {
        int r0, r1;
        wave_rows(ML, gw, NGW, r0, r1);
        rowpass_block<false, false, true, false, false>(r0, r1, a.in[0], nullptr, nullptr, MOD, -1, 0, 0.f, nullptr, preg, 0, 1024, H, lane);
        wave_rows(MC, gw, NGW, r0, r1);
        rowpass_block<false, false, true, false, false>(r0, r1, a.in[2], nullptr, nullptr, MOD, 16, 0, 0.f, nullptr, preg, 0, 1024, H + (size_t)ML * D, lane);
    }
    SEAM(1);
    if (IN(2)) run_gemm<1>(lds, H, (const bf16_t*)(ws + WS_W1IN), MA, 2 * DFF, D, (bf16_t*)(ws + WS_ACT), DFF, nullptr, 0);
    SEAM(2);
    bf16_t* const X1 = (bf16_t*)a.out;
    bf16_t* const X2 = (bf16_t*)(ws + WS_Y);
    const bool split3 = gridDim.x > 64;
    if (IN(3)) {
        const bf16_t* F = (const bf16_t*)(ws + WS_F);
        run_gemm<0>(lds, (const bf16_t*)(ws + WS_ACT), (const bf16_t*)(ws + WS_W1OUT), ML, D, DFF, (bf16_t*)(ws + WS_F), D, nullptr, 0);
        xcd_barrier(xbar);
        run_gemm<0>(lds, (const bf16_t*)(ws + WS_ACT) + (size_t)ML * DFF, (const bf16_t*)(ws + WS_W1OUT), MC, D, DFF, (bf16_t*)(ws + WS_F) + (size_t)ML * D, D, nullptr, 0);
        if (split3 && blockIdx.x >= 64) {
            const int gw3 = ((int)blockIdx.x - 64) * 8 + wave, NGW3 = ((int)gridDim.x - 64) * 8;
            int r0, r1; wave_rows(ML, gw3, NGW3, r0, r1);
            rowpass_block<true, true, true, false, true>(r0, r1, a.in[0], F, postg, MOD, -1, 2048, 0.5f, X1, preg + 1024, 3072, 4096, H, lane);
        }
    }
    SEAM(3);
    if (IN(4)) {
        const bf16_t* F = (const bf16_t*)(ws + WS_F);
        int r0, r1;
        if (!split3) { wave_rows(ML, gw, NGW, r0, r1); rowpass_block<true, true, true, false, true>(r0, r1, a.in[0], F, postg, MOD, -1, 2048, 0.5f, X1, preg + 1024, 3072, 4096, H, lane); }
        wave_rows(MC, gw, NGW, r0, r1);
        rowpass_block<true, false, true, false, false>(r0, r1, a.in[2], F + (size_t)ML * D, postg, MOD, 16, 2048, 0.5f, nullptr, preg + 1024, 3072, 4096, H + (size_t)ML * D, lane);
    }
    SEAM(4);
    if (IN(5)) run_gemm<0>(lds, H, (const bf16_t*)(ws + WS_WMIX), MA, UP, D, (bf16_t*)(ws + WS_U), UP, nullptr, 0);
    SEAM(5);
#ifndef NO_PREP
    if (IN(6)) prep_phase(a, lane, wave);
#endif
    SEAM(6);
    if (IN(7)) {
#ifndef NO_SCAN
#pragma unroll 1
        for (int rep = 0; rep <= ((a.ph_lo >> 8) & 3); ++rep) scan_phase(a, lds, tid, lane, wave);
#endif
#ifndef NO_ATTN
#pragma unroll 1
        for (int rep = 0; rep <= ((a.ph_lo >> 10) & 3); ++rep) attn_phase(a, lds, tid, lane, wave);
#endif
        run_gemm<0>(lds, (const bf16_t*)(ws + WS_AG), (const bf16_t*)(ws + WS_WG2), ML, 512, 256, (bf16_t*)(ws + WS_G), 512, nullptr, 0);
    }
    SEAM(7);
#ifndef NO_READ
    if (IN(8)) readout_phase(a, lane, wave);
#endif
    SEAM(8);
    if (IN(9)) run_gemm<2>(lds, H, (const bf16_t*)(ws + WS_WMIX) + (size_t)UP * D, ML, 2048, D, (bf16_t*)(ws + WS_UG), 2048, nullptr, 0);
    SEAM(9);
    if (IN(10)) {
        run_gemm<3>(lds, (const bf16_t*)(ws + WS_Y), (const bf16_t*)(ws + WS_WUPA), ML, D, 512, (bf16_t*)(ws + WS_MG), D, (const bf16_t*)(ws + WS_UG), 2048);
        run_gemm<4>(lds, (const bf16_t*)(ws + WS_O), (const bf16_t*)(ws + WS_WUPB), ML, D, 512, (bf16_t*)(ws + WS_MG), D, (const bf16_t*)(ws + WS_UG), 2048);
    }
    SEAM(10);
    if (IN(11)) run_gemm<0>(lds, (const bf16_t*)(ws + WS_MG), (const bf16_t*)(ws + WS_WOUT), ML, D, D, (bf16_t*)(ws + WS_F2), D, nullptr, 0);
    SEAM(11);
    if (IN(12)) {
        const bf16_t* F = (const bf16_t*)(ws + WS_F2); bf16_t* H3 = (bf16_t*)(ws + WS_H3);
        int r0, r1; wave_rows(ML, gw, NGW, r0, r1);
        rowpass_block<true, true, true, true, true>(r0, r1, X1, F, postg + 1024, MOD, -1, 5120, 1.0f, X2, preg + 2048, 6144, 7168, H3, lane);
    }
    SEAM(12);
    if (IN(13)) run_gemm<1>(lds, (const bf16_t*)(ws + WS_H3), (const bf16_t*)(ws + WS_W2IN), ML, 2 * DFF, D, (bf16_t*)(ws + WS_ACT2), DFF, nullptr, 0);
    SEAM(13);
    if (IN(14)) run_gemm<0>(lds, (const bf16_t*)(ws + WS_ACT2), (const bf16_t*)(ws + WS_W2OUT), ML, D, DFF, (bf16_t*)(ws + WS_F2), D, nullptr, 0);
    SEAM(14);
    if (IN(15)) {
        const bf16_t* F = (const bf16_t*)(ws + WS_F2);
        int r0, r1; wave_rows(ML, gw, NGW, r0, r1);
        rowpass_block<true, true, false, true, false>(r0, r1, X2, F, postg + 2048, MOD, -1, 8192, 0.5f, a.out, nullptr, 0, 0, nullptr, lane);
    }
}

extern "C" void kernel_launch(void* const* d_in, const int* in_sizes, int n_in, void* d_out, int out_size, void* d_ws, size_t ws_size, hipStream_t stream) {
    static int grid = 0;
    if (grid == 0) {
        if (n_in != 29 || ws_size < WS_END) { fprintf(stderr, "kernel_launch: unexpected n_in %d / ws %zu\n", n_in, ws_size); grid = -1; return; }
        int dev = 0, cus = 0, per_cu = 0;
        hipGetDevice(&dev);
        hipDeviceGetAttribute(&cus, hipDeviceAttributeMultiprocessorCount, dev);
        hipFuncSetAttribute((const void*)mk_fwd, hipFuncAttributeMaxDynamicSharedMemorySize, LDS_BYTES);
        hipOccupancyMaxActiveBlocksPerMultiprocessor(&per_cu, (const void*)mk_fwd, 512, LDS_BYTES);
        (void)hipGetLastError();
        if (per_cu < 1) { fprintf(stderr, "kernel_launch: occupancy query says %d blocks per CU\n", per_cu); per_cu = 1; }
        grid = cus;
    }
    if (grid < 0) return;
    if (hipMemsetAsync((char*)d_ws + WS_BAR, 0, 16384, stream) != hipSuccess) { fprintf(stderr, "kernel_launch: memset of barrier words failed\n"); return; }
    Args a{};
    for (int i = 0; i < 29; ++i) a.in[i] = (const float*)d_in[i];
    a.out = (float*)d_out; a.ws = (unsigned char*)d_ws; a.ph_lo = PROBE_BITS; a.ph_hi = 16;
    void* args[] = {&a};
    hipError_t e = hipLaunchCooperativeKernel((const void*)mk_fwd, dim3(grid), dim3(512), args, LDS_BYTES, stream);
    if (e != hipSuccess) fprintf(stderr, "cooperative launch failed: %s (grid %d)\n", hipGetErrorString(e), grid);
}
```

```cpp
#include <hip/hip_runtime.h>
#include <hip/hip_cooperative_groups.h>
#include <cstdio>
#include <cstdint>
namespace cg = cooperative_groups;

typedef unsigned short bf16_t;
typedef short bf16x8 __attribute__((ext_vector_type(8)));
typedef short s16x4 __attribute__((ext_vector_type(4)));
typedef float f32x2 __attribute__((ext_vector_type(2)));
typedef float f32x4 __attribute__((ext_vector_type(4)));
typedef float f32x16 __attribute__((ext_vector_type(16)));
typedef unsigned u32x2 __attribute__((ext_vector_type(2)));
typedef unsigned u32x4 __attribute__((ext_vector_type(4)));
typedef __bf16 bf16x2_t __attribute__((ext_vector_type(2)));
typedef short v4i16_t __attribute__((ext_vector_type(4)));
#define LAS __attribute__((address_space(3)))
#define DI __device__ __forceinline__

DI unsigned pk2(float lo, float hi) { f32x2 v = {lo, hi}; bf16x2_t b = __builtin_convertvector(v, bf16x2_t); return __builtin_bit_cast(unsigned, b); }
DI float bflo(unsigned u) { return __builtin_bit_cast(float, u << 16); }
DI float bfhi(unsigned u) { return __builtin_bit_cast(float, u & 0xffff0000u); }
DI float wave_sum(float v) {
    v += __builtin_bit_cast(float, __builtin_amdgcn_update_dpp(0, __builtin_bit_cast(int, v), 0xB1, 0xF, 0xF, true));
    v += __builtin_bit_cast(float, __builtin_amdgcn_update_dpp(0, __builtin_bit_cast(int, v), 0x4E, 0xF, 0xF, true));
    v += __builtin_bit_cast(float, __builtin_amdgcn_update_dpp(0, __builtin_bit_cast(int, v), 0x141, 0xF, 0xF, true));
    v += __builtin_bit_cast(float, __builtin_amdgcn_update_dpp(0, __builtin_bit_cast(int, v), 0x140, 0xF, 0xF, true));
    const int vi = __builtin_bit_cast(int, v);
    const float r0 = __builtin_bit_cast(float, __builtin_amdgcn_readlane(vi, 0)), r1 = __builtin_bit_cast(float, __builtin_amdgcn_readlane(vi, 16));
    const float r2 = __builtin_bit_cast(float, __builtin_amdgcn_readlane(vi, 32)), r3 = __builtin_bit_cast(float, __builtin_amdgcn_readlane(vi, 48));
    return (r0 + r1) + (r2 + r3);
}
DI float dpp_f(float x, const int ctrl_sel) {
    int xi = __builtin_bit_cast(int, x);
    int r;
    if (ctrl_sel == 0) r = __builtin_amdgcn_update_dpp(0, xi, 0xB1, 0xF, 0xF, true);
    else if (ctrl_sel == 1) r = __builtin_amdgcn_update_dpp(0, xi, 0x4E, 0xF, 0xF, true);
    else r = __builtin_amdgcn_update_dpp(0, xi, 0x141, 0xF, 0xF, true);
    return __builtin_bit_cast(float, r);
}
DI float sum8(float x) { x += dpp_f(x, 0); x += dpp_f(x, 1); x += dpp_f(x, 2); return x; }
DI float fast_sigmoid(float x) { return __builtin_amdgcn_rcpf(1.f + __builtin_amdgcn_exp2f(-1.4426950408889634f * x)); }
DI float fma_s(float a, float b, float c) { float d; asm("v_fma_f32 %0, %1, %2, %3" : "=v"(d) : "v"(a), "v"(b), "v"(c)); return d; }
DI float nfma_s(float a, float b, float c) { float d; asm("v_fma_f32 %0, -%1, %2, %3" : "=v"(d) : "v"(a), "v"(b), "v"(c)); return d; }
DI float mul_s(float a, float b) { float d; asm("v_mul_f32_e32 %0, %1, %2" : "=v"(d) : "v"(a), "v"(b)); return d; }
DI float max3_s(float a, float b, float c) { float d; asm("v_max3_f32 %0, %1, %2, %3" : "=v"(d) : "v"(a), "v"(b), "v"(c)); return d; }
DI int crow(int r, int hi) { return (r & 3) + 8 * (r >> 2) + 4 * hi; }

constexpr int D = 1024, NB = 16, T = 2048, CT = 256, DFF = 2816;
constexpr int ML = NB * T;
constexpr int MC = NB * CT;
constexpr int MA = ML + MC;
constexpr int UP = 3584;
constexpr float EPS = 1e-6f;
constexpr size_t MiB = 1u << 20;
constexpr size_t WS_MOD = 0;
constexpr size_t WS_W1IN = 1 * MiB, WS_W1OUT = 12 * MiB, WS_WMIX = 18 * MiB, WS_WUPA = 29 * MiB, WS_WUPB = 30 * MiB, WS_WOUT = 31 * MiB;
constexpr size_t WS_W2IN = 33 * MiB, WS_W2OUT = 44 * MiB, WS_WG2 = 49 * MiB + 512 * 1024;
constexpr size_t WS_H = 50 * MiB, WS_F = 122 * MiB, WS_ACT = 194 * MiB, WS_U = 122 * MiB, WS_Y = 374 * MiB, WS_BON = 438 * MiB;
constexpr size_t WS_G = 440 * MiB, WS_O = 472 * MiB, WS_AG = 1 * MiB, WS_UG = 122 * MiB, WS_MG = 250 * MiB, WS_F2 = 50 * MiB, WS_H3 = 122 * MiB;
constexpr size_t WS_ACT2 = 194 * MiB, WS_END = 504 * MiB;
constexpr int LDS_BYTES = 163840;
constexpr size_t WS_BAR = 768 * 1024;
constexpr int LDS_BARST = 163072;

#ifndef PROBE_BITS
#define PROBE_BITS 0
#endif
struct Args { const float* in[29]; float* out; unsigned char* ws; int ph_lo, ph_hi; };

namespace pg8 {
constexpr int BM = 256, BK = 64, HALF = 128, HTB = HALF * BK * 2, NXCD = 8, WGM = 8;
DI int lds_byte(int r, int c) { const int st = (r >> 4) * 2 + (c >> 5), rr = r & 15, cc = c & 31, ob = rr * 64 + cc * 2; return st * 1024 + (ob ^ (((ob >> 9) & 1) << 5)); }
DI void stage_rc(int b, int& R, int& C) { const int st = b / 1024, sb = b % 1024, swz = sb ^ (((sb >> 9) & 1) << 5); R = (st >> 1) * 16 + swz / 64; C = (st & 1) * 32 + (swz % 64) / 2; }
DI int perm32(int rho) { const int n = rho >> 4, i = rho & 15; return 8 * (i >> 2) + 4 * n + (i & 3); }
struct Unit { int pm, pn; };
struct Gemm { const bf16_t* A; const bf16_t* Bt; int M, N, K; };
struct StaticOrder {
    int nM, nN, nwg, G, c;
    DI void init(int M, int N, int G_, int c_) { nM = M / BM; nN = N / BM; nwg = nM * nN; G = G_; c = c_; }
    DI bool next(int i, Unit& u) const {
        const long L = (long)i * G + c; if (L >= nwg) return false;
        int wgid = (int)L; { const int q = nwg / NXCD, r = nwg % NXCD, xcd = wgid % NXCD, off = wgid / NXCD; wgid = (xcd < r ? xcd * (q + 1) : r * (q + 1) + (xcd - r) * q) + off; }
        const int nig = WGM * nN, gid = wgid / nig, fm = gid * WGM, gsz = (nM - fm) < WGM ? (nM - fm) : WGM;
        u.pm = fm + ((wgid % nig) % gsz); u.pn = (wgid % nig) / gsz; return true;
    }
    DI void a_ready(const Unit&) const {}
    DI void done(const Unit&) const {}
};

template <int MODE> struct Epi {
    static constexpr bool PERM = true, AFTER_DRAIN = false;
    bf16_t* O; int ldc; const bf16_t* G; int ldg;
    DI void operator()(const f32x4 (&acc)[2][2][4][2], const Unit& u, int wr, int wc, int fr, int fq) const {
        const int row0 = u.pm * BM + wr * 64 + fr;
#pragma unroll
        for (int ai = 0; ai < 2; ++ai)
#pragma unroll
            for (int m = 0; m < 4; ++m) {
                const size_t row = (size_t)(row0 + ai * HALF + m * 16);
                if (MODE == 1) {
                    const int col = u.pn * 128 + wc * 32 + 8 * fq;
                    float v[8];
#pragma unroll
                    for (int n = 0; n < 2; ++n)
#pragma unroll
                        for (int j = 0; j < 4; ++j) { const float g = acc[ai][0][m][n][j], up = acc[ai][1][m][n][j]; v[4 * n + j] = (g * up) * __builtin_amdgcn_rcpf(1.f + __builtin_amdgcn_exp2f(g)); }
                    u32x4 w; w.x = pk2(v[0], v[1]); w.y = pk2(v[2], v[3]); w.z = pk2(v[4], v[5]); w.w = pk2(v[6], v[7]);
                    *(u32x4*)(O + row * ldc + col) = w;
                } else {
#pragma unroll
                    for (int bj = 0; bj < 2; ++bj) {
                        const int col = u.pn * BM + bj * HALF + wc * 32 + 8 * fq;
                        float v[8];
#pragma unroll
                        for (int n = 0; n < 2; ++n)
#pragma unroll
                            for (int j = 0; j < 4; ++j) v[4 * n + j] = acc[ai][bj][m][n][j];
                        if (MODE == 2) {
#pragma unroll
                            for (int j = 0; j < 8; ++j) v[j] = fast_sigmoid(v[j]);
                        }
                        if (MODE == 3 || MODE == 4) {
                            const u32x4 g = *(const u32x4*)(G + row * ldg + (MODE == 4 ? 1024 : 0) + col);
                            v[0] *= bflo(g.x); v[1] *= bfhi(g.x); v[2] *= bflo(g.y); v[3] *= bfhi(g.y); v[4] *= bflo(g.z); v[5] *= bfhi(g.z); v[6] *= bflo(g.w); v[7] *= bfhi(g.w);
                        }
                        if (MODE == 4) {
                            const u32x4 p = *(const u32x4*)(O + row * ldc + col);
                            v[0] += bflo(p.x); v[1] += bfhi(p.x); v[2] += bflo(p.y); v[3] += bfhi(p.y); v[4] += bflo(p.z); v[5] += bfhi(p.z); v[6] += bflo(p.w); v[7] += bfhi(p.w);
                        }
                        u32x4 w; w.x = pk2(v[0], v[1]); w.y = pk2(v[2], v[3]); w.z = pk2(v[4], v[5]); w.w = pk2(v[6], v[7]);
                        *(u32x4*)(O + row * ldc + col) = w;
                    }
                }
            }
    }
};

template <class EpiT, class Sched, bool ALIGN_EPI = false, bool SP2 = false>
DI void gemm_phase(LAS unsigned char* lds, const Gemm g, const Sched& S, const EpiT& E) {
    const int tid = threadIdx.x, wid = __builtin_amdgcn_readfirstlane(tid >> 6), lane = tid & 63, wr = wid >> 2, wc = wid & 3, fr = lane & 15, fq = lane >> 4;
    const int K = g.K, nt = K / BK;
    unsigned voffA[2], voffB[2];
#pragma unroll
    for (int i = 0; i < 2; ++i) { int R, C; stage_rc(tid * 16 + i * 8192, R, C); const int Rb = EpiT::PERM ? ((R & ~31) + perm32(R & 31)) : R;
        voffA[i] = (unsigned)(R * K + C) * 2u; voffB[i] = (unsigned)(Rb * K + C) * 2u; }
    const size_t kstep = (size_t)(BK * 2);
    const size_t hstep = (size_t)HALF * K * 2;
    const size_t tstep = 2 * hstep;
    const unsigned ldsw = (unsigned)wid * 1024u;
    const int aoff = lds_byte(wr * 64 + fr, fq * 8), boff = lds_byte(wc * 32 + fr, fq * 8);
#define PG8_SA(b, h) (((b) * 2 + (h)) * HTB)
#define PG8_SB(b, h) ((4 + (b) * 2 + (h)) * HTB)
#define PG8_STAGE(bufoff, gbase, voff) do { _Pragma("unroll") for (int _i = 0; _i < 2; ++_i) \
        __builtin_amdgcn_global_load_lds((const unsigned*)((const char*)(gbase) + (voff)[_i]), (LAS unsigned*)(lds + (bufoff) + ldsw + _i * 8192), 16, 0, 0); } while (0)
#define PG8_LDA(dst, b, h) do { _Pragma("unroll") for (int m = 0; m < 4; ++m) _Pragma("unroll") for (int k = 0; k < 2; ++k) dst[m][k] = *(const LAS bf16x8*)(lds + PG8_SA(b, h) + aoff + m * 2048 + k * 1024); } while (0)
#define PG8_LDB(dst, b, h) do { _Pragma("unroll") for (int n = 0; n < 2; ++n) _Pragma("unroll") for (int k = 0; k < 2; ++k) dst[n][k] = *(const LAS bf16x8*)(lds + PG8_SB(b, h) + boff + n * 2048 + k * 1024); } while (0)
#define PG8_MMA(ai, bj, At, Bt) do { __builtin_amdgcn_s_setprio(1); _Pragma("unroll") for (int m = 0; m < 4; ++m) _Pragma("unroll") for (int n = 0; n < 2; ++n) _Pragma("unroll") for (int k = 0; k < 2; ++k) \
        acc[ai][bj][m][n] = __builtin_amdgcn_mfma_f32_16x16x32_bf16(Bt[n][k], At[m][k], acc[ai][bj][m][n], 0, 0, 0); __builtin_amdgcn_s_setprio(0); } while (0)
#define PG8_WAIT_V(n) asm volatile("s_waitcnt vmcnt(" #n ")" ::: "memory")
#define PG8_WAIT_L(n) asm volatile("s_waitcnt lgkmcnt(" #n ")" ::: "memory")
#define PG8_BAR __builtin_amdgcn_s_barrier()
#define PG8_SCHED __builtin_amdgcn_sched_barrier(0)
    Unit cur, nxt; int ui = 0;
    if (!S.next(0, cur)) return;
    f32x4 acc[2][2][4][2];
#pragma unroll
    for (int a = 0; a < 2; ++a)
#pragma unroll
        for (int b = 0; b < 2; ++b)
#pragma unroll
            for (int m = 0; m < 4; ++m)
#pragma unroll
                for (int n = 0; n < 2; ++n) acc[a][b][m][n] = (f32x4){0.f, 0.f, 0.f, 0.f};
    bf16x8 At[4][2], B0[2][2], B1[2][2];
    const char* cA = (const char*)g.A + (size_t)cur.pm * tstep; const char* cB = (const char*)g.Bt + (size_t)cur.pn * tstep;
    S.a_ready(cur);
    if constexpr (SP2) {
        PG8_STAGE(PG8_SB(0, 0), cB, voffB); PG8_STAGE(PG8_SB(0, 1), cB + hstep, voffB); PG8_STAGE(PG8_SA(0, 0), cA, voffA); PG8_STAGE(PG8_SA(0, 1), cA + hstep, voffA);
        if (wr == 1) PG8_BAR;
        PG8_WAIT_V(2); PG8_BAR;
        PG8_STAGE(PG8_SB(1, 0), cB + kstep, voffB); PG8_STAGE(PG8_SA(1, 0), cA + kstep, voffA); PG8_STAGE(PG8_SB(1, 1), cB + hstep + kstep, voffB);
        PG8_WAIT_V(6); PG8_BAR;
    } else {
        PG8_STAGE(PG8_SB(0, 0), cB, voffB); PG8_STAGE(PG8_SA(0, 0), cA, voffA); PG8_STAGE(PG8_SB(0, 1), cB + hstep, voffB); PG8_STAGE(PG8_SA(0, 1), cA + hstep, voffA);
        if (wr == 1) PG8_BAR;
        PG8_WAIT_V(4); PG8_BAR;
        PG8_STAGE(PG8_SB(1, 0), cB + kstep, voffB); PG8_STAGE(PG8_SA(1, 0), cA + kstep, voffA); PG8_STAGE(PG8_SB(1, 1), cB + hstep + kstep, voffB);
        PG8_WAIT_V(6); PG8_BAR;
    }
    for (;;) {
        const bool has_next = S.next(ui + 1, nxt);
        const char* nA = has_next ? (const char*)g.A + (size_t)nxt.pm * tstep : cA; const char* nB = has_next ? (const char*)g.Bt + (size_t)nxt.pn * tstep : cB;
        for (int t = 0; t < nt; t += 2) {
            const bool last = (t == nt - 2);
            const char* a1 = cA + (size_t)(t + 1) * kstep;
            const char* a2 = last ? nA : cA + (size_t)(t + 2) * kstep; const char* b2 = last ? nB : cB + (size_t)(t + 2) * kstep;
            const char* a3 = a2 + kstep; const char* b3 = b2 + kstep;
            if (last && has_next) S.a_ready(nxt);
            if constexpr (SP2) {
            PG8_LDB(B0, 0, 0); PG8_LDB(B1, 0, 1); PG8_SCHED; PG8_LDA(At, 0, 0); PG8_STAGE(PG8_SA(1, 1), a1 + hstep, voffA);
            PG8_WAIT_V(8); PG8_WAIT_L(0); PG8_BAR; PG8_MMA(0, 0, At, B0); PG8_MMA(0, 1, At, B1); PG8_BAR; PG8_SCHED;
            PG8_LDA(At, 0, 1); PG8_STAGE(PG8_SB(0, 0), b2, voffB); PG8_STAGE(PG8_SB(0, 1), b2 + hstep, voffB); PG8_STAGE(PG8_SA(0, 0), a2, voffA);
            PG8_WAIT_V(8); PG8_WAIT_L(0); PG8_BAR; PG8_MMA(1, 0, At, B0); PG8_MMA(1, 1, At, B1); PG8_BAR; PG8_SCHED;
            PG8_LDB(B0, 1, 0); PG8_LDB(B1, 1, 1); PG8_SCHED; PG8_LDA(At, 1, 0); PG8_STAGE(PG8_SA(0, 1), a2 + hstep, voffA);
            PG8_WAIT_V(8); PG8_WAIT_L(0); PG8_BAR; PG8_MMA(0, 0, At, B0); PG8_MMA(0, 1, At, B1); PG8_BAR; PG8_SCHED;
            PG8_LDA(At, 1, 1); PG8_STAGE(PG8_SB(1, 0), b3, voffB); PG8_STAGE(PG8_SB(1, 1), b3 + hstep, voffB); PG8_STAGE(PG8_SA(1, 0), a3, voffA);
            PG8_WAIT_V(8); PG8_WAIT_L(0); PG8_BAR; PG8_MMA(1, 0, At, B0); PG8_MMA(1, 1, At, B1); PG8_BAR; PG8_SCHED;
            } else {
            PG8_LDB(B0, 0, 0); PG8_SCHED; PG8_LDA(At, 0, 0); PG8_STAGE(PG8_SA(1, 1), a1 + hstep, voffA);
            PG8_WAIT_L(8); PG8_BAR; PG8_WAIT_L(0); PG8_MMA(0, 0, At, B0); PG8_BAR; PG8_SCHED;
            PG8_LDB(B1, 0, 1); PG8_STAGE(PG8_SB(0, 0), b2, voffB);
            PG8_BAR; PG8_WAIT_L(0); PG8_MMA(0, 1, At, B1); PG8_BAR;
            PG8_LDA(At, 0, 1); PG8_STAGE(PG8_SA(0, 0), a2, voffA);
            PG8_BAR; PG8_WAIT_L(0); PG8_MMA(1, 0, At, B0); PG8_BAR; PG8_SCHED;
            PG8_STAGE(PG8_SB(0, 1), b2 + hstep, voffB);
            PG8_WAIT_V(6); PG8_BAR; PG8_MMA(1, 1, At, B1); PG8_BAR;
            PG8_LDB(B0, 1, 0); PG8_SCHED; PG8_LDA(At, 1, 0); PG8_STAGE(PG8_SA(0, 1), a2 + hstep, voffA);
            PG8_WAIT_L(8); PG8_BAR; PG8_WAIT_L(0); PG8_MMA(0, 0, At, B0); PG8_BAR; PG8_SCHED;
            PG8_LDB(B1, 1, 1); PG8_STAGE(PG8_SB(1, 0), b3, voffB);
            PG8_BAR; PG8_WAIT_L(0); PG8_MMA(0, 1, At, B1); PG8_BAR;
            PG8_LDA(At, 1, 1); PG8_STAGE(PG8_SA(1, 0), a3, voffA);
            PG8_BAR; PG8_WAIT_L(0); PG8_MMA(1, 0, At, B0); PG8_BAR; PG8_SCHED;
            PG8_STAGE(PG8_SB(1, 1), b3 + hstep, voffB);
            PG8_WAIT_V(6); PG8_BAR; PG8_MMA(1, 1, At, B1); PG8_BAR;
            }
        }
        if constexpr (ALIGN_EPI) { if (wr == 0) PG8_BAR; }
        if constexpr (!EpiT::AFTER_DRAIN) { E(acc, cur, wr, wc, fr, fq); S.done(cur); }
        if (!has_next) break;
#pragma unroll
        for (int a = 0; a < 2; ++a)
#pragma unroll
            for (int b = 0; b < 2; ++b)
#pragma unroll
                for (int m = 0; m < 4; ++m)
#pragma unroll
                    for (int n = 0; n < 2; ++n) acc[a][b][m][n] = (f32x4){0.f, 0.f, 0.f, 0.f};
        cur = nxt; cA = nA; cB = nB; ++ui;
        if constexpr (ALIGN_EPI) { if (wr == 1) PG8_BAR; }
    }
    PG8_WAIT_V(0);
    if constexpr (!ALIGN_EPI) { if (wr == 0) PG8_BAR; }
    PG8_BAR;
#undef PG8_SA
#undef PG8_SB
#undef PG8_STAGE
#undef PG8_LDA
#undef PG8_LDB
#undef PG8_MMA
#undef PG8_WAIT_V
#undef PG8_WAIT_L
#undef PG8_BAR
#undef PG8_SCHED
}
}

template <int MODE>
DI void run_gemm(LAS unsigned char* lds, const bf16_t* A, const bf16_t* Bt, int M, int N, int K, bf16_t* O, int ldc, const bf16_t* G, int ldg) {
    pg8::Gemm g{A, Bt, M, N, K}; pg8::StaticOrder S; S.init(M, N, (int)gridDim.x, (int)blockIdx.x);
    pg8::Epi<MODE> E{O, ldc, G, ldg};
    pg8::gemm_phase<pg8::Epi<MODE>, pg8::StaticOrder, true, true>(lds, g, S, E);
    __syncthreads();
}

DI int rowmap(int mode, int n) {
    if (mode == 1) { const int g = n >= DFF ? 1 : 0; const int j = n - g * DFF; return (j >> 7) * 256 + g * 128 + (j & 127); }
    if (mode == 2) return n < 1920 ? n : n + 128;
    return n;
}
DI void transpose_item(const float* W, int N, bf16_t* WT, int KP, int mode, LAS float* scr, int item, int lane) {
    const int nblk = N / 64, kb = item / nblk, nb = item % nblk, k0 = 64 * kb, n0 = 64 * nb;
    const float* src = W + (size_t)k0 * N + n0 + lane;
#pragma unroll 16
    for (int i = 0; i < 64; ++i) scr[i * 65 + lane] = src[(size_t)i * N];
    asm volatile("s_waitcnt lgkmcnt(0)" ::: "memory");
    const int c = lane & 7;
    const float wsc = mode == 1 ? (n0 < DFF ? -1.4426950408889634f : -0.6931471805599453f) : 1.f;
#pragma unroll
    for (int j = 0; j < 8; ++j) { const int n = (lane >> 3) + 8 * j; const LAS float* s = scr + (8 * c) * 65 + n;
        u32x4 o; o.x = pk2(s[0 * 65] * wsc, s[1 * 65] * wsc); o.y = pk2(s[2 * 65] * wsc, s[3 * 65] * wsc); o.z = pk2(s[4 * 65] * wsc, s[5 * 65] * wsc); o.w = pk2(s[6 * 65] * wsc, s[7 * 65] * wsc);
        *(u32x4*)(WT + (size_t)rowmap(mode, n0 + n) * KP + k0 + 8 * c) = o; }
    asm volatile("s_waitcnt lgkmcnt(0)" ::: "memory");
}

DI void p0_phase(const Args& a, LAS unsigned char* lds, int tid, int lane, int wave) {
    unsigned char* ws = a.ws;
    {
        const float* c = a.in[1]; const float* cctx = a.in[3]; const float* ada_w = a.in[4]; const float* ada_b = a.in[5];
        float* MOD = (float*)(ws + WS_MOD);
        LAS float* Sx = (LAS float*)lds;
        LAS float* RED = (LAS float*)(lds + 81920);
        for (int item = blockIdx.x; item < 144; item += gridDim.x) {
            for (int idx = tid; idx < 1024 * 20; idx += 512) { const int k = idx / 20, i = idx % 20; float v = 0.f;
                if (i < 16) v = c[i * 1024 + k]; else if (i == 16) v = cctx[k];
                Sx[idx] = v / (1.f + __expf(-v)); }
            __syncthreads();
            const int n0 = item * 64;
            float acc[17];
#pragma unroll
            for (int i = 0; i < 17; ++i) acc[i] = 0.f;
            for (int k = wave * 128; k < wave * 128 + 128; ++k) {
                const float wv = ada_w[(size_t)k * 9216 + n0 + lane];
                const LAS f32x4* sp = (const LAS f32x4*)(Sx + k * 20);
                const f32x4 s0 = sp[0], s1 = sp[1], s2 = sp[2], s3 = sp[3]; const float s16 = Sx[k * 20 + 16];
#pragma unroll
                for (int j = 0; j < 4; ++j) { acc[j] += s0[j] * wv; acc[4 + j] += s1[j] * wv; acc[8 + j] += s2[j] * wv; acc[12 + j] += s3[j] * wv; }
                acc[16] += s16 * wv;
            }
#pragma unroll
            for (int i = 0; i < 17; ++i) RED[(wave * 17 + i) * 64 + lane] = acc[i];
            __syncthreads();
            for (int idx = tid; idx < 17 * 64; idx += 512) { const int i = idx / 64, n = idx % 64; float s = 0.f;
#pragma unroll
                for (int w = 0; w < 8; ++w) s += RED[(w * 17 + i) * 64 + n];
                MOD[i * 9216 + n0 + n] = s + ada_b[n0 + n]; }
            __syncthreads();
        }
    }
    {
        LAS float* scr = (LAS float*)(lds + wave * 16640);
        const int gw = blockIdx.x * 8 + wave, NGW = gridDim.x * 8;
        constexpr int I1 = 16 * 88, I2 = 44 * 16, I3 = 16 * 86, I4 = 8 * 16, I6 = 16 * 16, I9 = 2 * 8;
        constexpr int NITEMS = I1 + I2 + I3 + I4 + I4 + I6 + I1 + I2 + I9;
        for (int it = gw; it < NITEMS; it += NGW) {
            int r = it;
            if (r < I1) { transpose_item(a.in[8], 2 * DFF, (bf16_t*)(ws + WS_W1IN), 1024, 1, scr, r, lane); continue; } r -= I1;
            if (r < I2) { transpose_item(a.in[9], 1024, (bf16_t*)(ws + WS_W1OUT), DFF, 0, scr, r, lane); continue; } r -= I2;
            if (r < I3) { transpose_item(a.in[10], 5504, (bf16_t*)(ws + WS_WMIX), 1024, 2, scr, r, lane); continue; } r -= I3;
            if (r < I4) { transpose_item(a.in[24], 1024, (bf16_t*)(ws + WS_WUPA), 512, 0, scr, r, lane); continue; } r -= I4;
            if (r < I4) { transpose_item(a.in[25], 1024, (bf16_t*)(ws + WS_WUPB), 512, 0, scr, r, lane); continue; } r -= I4;
            if (r < I6) { transpose_item(a.in[26], 1024, (bf16_t*)(ws + WS_WOUT), 1024, 0, scr, r, lane); continue; } r -= I6;
            if (r < I1) { transpose_item(a.in[27], 2 * DFF, (bf16_t*)(ws + WS_W2IN), 1024, 1, scr, r, lane); continue; } r -= I1;
            if (r < I2) { transpose_item(a.in[28], 1024, (bf16_t*)(ws + WS_W2OUT), DFF, 0, scr, r, lane); continue; } r -= I2;
            transpose_item(a.in[16], 512, (bf16_t*)(ws + WS_WG2), 256, 0, scr, r, lane);
        }
        const int gt = blockIdx.x * 512 + tid, NGT = gridDim.x * 512;
        const u32x4 z = {0u, 0u, 0u, 0u};
        for (int i = gt; i < 128 * 1024 / 8; i += NGT) *(u32x4*)(ws + WS_WMIX + (size_t)1920 * 1024 * 2 + (size_t)i * 16) = z;
        for (int i = gt; i < 512 * 16; i += NGT) { const int rr = i >> 4, cc = i & 15; *(u32x4*)(ws + WS_WG2 + (size_t)rr * 512 + 256 + cc * 16) = z; }
    }
}

template <bool HAS_F, bool WRITE_X, bool WRITE_H, bool XIN_BF = false, bool XOUT_BF = false>
DI void rowpass(const void* xin, const bf16_t* f, const float* postg, const float* gate, float alpha, void* xout,
                const float* preg, const float* shift, const float* scale, bf16_t* hout, int lane) {
    f32x4 v[4];
#pragma unroll
    for (int j = 0; j < 4; ++j) {
        if (XIN_BF) { const u32x2 raw = ((const u32x2*)xin)[lane + 64 * j]; v[j] = (f32x4){bflo(raw.x), bfhi(raw.x), bflo(raw.y), bfhi(raw.y)}; }
        else v[j] = ((const f32x4*)xin)[lane + 64 * j];
    }
    if (HAS_F) {
        f32x4 fv[4]; float s = 0.f;
#pragma unroll
        for (int j = 0; j < 4; ++j) { const u32x2 raw = ((const u32x2*)f)[lane + 64 * j]; fv[j] = (f32x4){bflo(raw.x), bfhi(raw.x), bflo(raw.y), bfhi(raw.y)};
            s += (fv[j].x * fv[j].x + fv[j].y * fv[j].y) + (fv[j].z * fv[j].z + fv[j].w * fv[j].w); }
        const float rs = alpha * rsqrtf(wave_sum(s) * (1.f / 1024.f) + EPS);
#pragma unroll
        for (int j = 0; j < 4; ++j) { const f32x4 pg = ((const f32x4*)postg)[lane + 64 * j], gt = ((const f32x4*)gate)[lane + 64 * j]; v[j] += rs * gt * fv[j] * pg; }
    }
    if (WRITE_X) {
#pragma unroll
        for (int j = 0; j < 4; ++j) {
            if (XOUT_BF) { u32x2 o; o.x = pk2(v[j].x, v[j].y); o.y = pk2(v[j].z, v[j].w); ((u32x2*)xout)[lane + 64 * j] = o; }
            else ((f32x4*)xout)[lane + 64 * j] = v[j];
        }
    }
    if (WRITE_H) {
        float s2 = 0.f;
#pragma unroll
        for (int j = 0; j < 4; ++j) s2 += (v[j].x * v[j].x + v[j].y * v[j].y) + (v[j].z * v[j].z + v[j].w * v[j].w);
        const float rstd = rsqrtf(wave_sum(s2) * (1.f / 1024.f) + EPS);
#pragma unroll
        for (int j = 0; j < 4; ++j) { const f32x4 g = ((const f32x4*)preg)[lane + 64 * j], sc = ((const f32x4*)scale)[lane + 64 * j], sh = ((const f32x4*)shift)[lane + 64 * j];
            const f32x4 hv = v[j] * rstd * g * (1.f + sc) + sh;
            u32x2 o; o.x = pk2(hv.x, hv.y); o.y = pk2(hv.z, hv.w);
            ((u32x2*)hout)[lane + 64 * j] = o; }
    }
}

template <bool HAS_F, bool WRITE_X, bool WRITE_H, bool XIN_BF, bool XOUT_BF>
DI void rowpass_block(int r0, int r1, const void* xin, const bf16_t* f, const float* postg, const float* MODv, int mod_fixed, int goff, float alpha, void* xout,
                      const float* preg, int shoff, int scoff, bf16_t* hout, int lane) {
    if (r0 >= r1) return;
    f32x4 Av[4], Bv[4], Cv[4];
    int curb = -2;
    f32x4 xr[4]; u32x2 xb[4], fr[4];
#define RB_LOAD(rr) do { _Pragma("unroll") for (int j = 0; j < 4; ++j) { \
        if (XIN_BF) xb[j] = ((const u32x2*)((const bf16_t*)xin + (size_t)(rr) * D))[lane + 64 * j]; else xr[j] = ((const f32x4*)((const float*)xin + (size_t)(rr) * D))[lane + 64 * j]; \
        if (HAS_F) fr[j] = ((const u32x2*)(f + (size_t)(rr) * D))[lane + 64 * j]; } } while (0)
    RB_LOAD(r0);
    for (int row = r0; row < r1; ++row) {
        const int bi = mod_fixed >= 0 ? mod_fixed : row / T;
        if (bi != curb) {
            curb = bi; const float* m = MODv + (size_t)bi * 9216;
#pragma unroll
            for (int j = 0; j < 4; ++j) {
                if (HAS_F) Av[j] = alpha * ((const f32x4*)(m + goff))[lane + 64 * j] * ((const f32x4*)postg)[lane + 64 * j];
                if (WRITE_H) { Bv[j] = ((const f32x4*)preg)[lane + 64 * j] * (1.f + ((const f32x4*)(m + scoff))[lane + 64 * j]); Cv[j] = ((const f32x4*)(m + shoff))[lane + 64 * j]; }
            }
        }
        f32x4 v[4], fv[4];
#pragma unroll
        for (int j = 0; j < 4; ++j) {
            if (XIN_BF) v[j] = (f32x4){bflo(xb[j].x), bfhi(xb[j].x), bflo(xb[j].y), bfhi(xb[j].y)}; else v[j] = xr[j];
            if (HAS_F) fv[j] = (f32x4){bflo(fr[j].x), bfhi(fr[j].x), bflo(fr[j].y), bfhi(fr[j].y)};
        }
        if (row + 1 < r1) RB_LOAD(row + 1);
        if (HAS_F) {
            float sq = 0.f;
#pragma unroll
            for (int j = 0; j < 4; ++j) sq += (fv[j].x * fv[j].x + fv[j].y * fv[j].y) + (fv[j].z * fv[j].z + fv[j].w * fv[j].w);
            const float rs = rsqrtf(wave_sum(sq) * (1.f / 1024.f) + EPS);
#pragma unroll
            for (int j = 0; j < 4; ++j) v[j] += rs * Av[j] * fv[j];
        }
        if (WRITE_X) {
#pragma unroll
            for (int j = 0; j < 4; ++j) {
                if (XOUT_BF) { u32x2 o; o.x = pk2(v[j].x, v[j].y); o.y = pk2(v[j].z, v[j].w); ((u32x2*)((bf16_t*)xout + (size_t)row * D))[lane + 64 * j] = o; }
                else ((f32x4*)((float*)xout + (size_t)row * D))[lane + 64 * j] = v[j];
            }
        }
        if (WRITE_H) {
            float s2 = 0.f;
#pragma unroll
            for (int j = 0; j < 4; ++j) s2 += (v[j].x * v[j].x + v[j].y * v[j].y) + (v[j].z * v[j].z + v[j].w * v[j].w);
            const float rstd = rsqrtf(wave_sum(s2) * (1.f / 1024.f) + EPS);
#pragma unroll
            for (int j = 0; j < 4; ++j) { const f32x4 hv = v[j] * rstd * Bv[j] + Cv[j]; u32x2 o; o.x = pk2(hv.x, hv.y); o.y = pk2(hv.z, hv.w); ((u32x2*)(hout + (size_t)row * D))[lane + 64 * j] = o; }
        }
    }
#undef RB_LOAD
}
DI void wave_rows(int n, int w, int nw, int& r0, int& r1) { const int per = (n + nw - 1) / nw; r0 = w * per; r1 = r0 + per < n ? r0 + per : n; }

DI void prep_phase(const Args& a, int lane, int wave) {
    bf16_t* U = (bf16_t*)(a.ws + WS_U); bf16_t* AG = (bf16_t*)(a.ws + WS_AG);
    const float* shw = a.in[11];
    const int gw = blockIdx.x * 8 + wave, NGW = gridDim.x * 8;
    for (int row = gw; row < ML; row += NGW) {
        const int t = row & (T - 1);
        bf16_t* ur = U + (size_t)row * UP;
        u32x2 o = {0u, 0u};
        if (lane < 32) {
            const int col = 1792 + 4 * lane;
            const u32x2 cu = *(const u32x2*)(ur + col);
            u32x2 pv = {0u, 0u}, nx = {0u, 0u};
            if (t > 0) pv = *(const u32x2*)(ur - UP + col);
            if (t < T - 1) nx = *(const u32x2*)(ur + UP + col);
            const f32x4 w0 = *(const f32x4*)(shw + col), w1 = *(const f32x4*)(shw + 1920 + col), w2 = *(const f32x4*)(shw + 3840 + col);
            const float v0 = bflo(pv.x) * w0.x + bflo(cu.x) * w1.x + bflo(nx.x) * w2.x;
            const float v1 = bfhi(pv.x) * w0.y + bfhi(cu.x) * w1.y + bfhi(nx.x) * w2.y;
            const float v2 = bflo(pv.y) * w0.z + bflo(cu.y) * w1.z + bflo(nx.y) * w2.z;
            const float v3 = bfhi(pv.y) * w0.w + bfhi(cu.y) * w1.w + bfhi(nx.y) * w2.w;
            o.x = pk2(fast_sigmoid(v0), fast_sigmoid(v1)); o.y = pk2(fast_sigmoid(v2), fast_sigmoid(v3));
        }
        *(u32x2*)(AG + (size_t)row * 256 + 4 * lane) = o;
        {
            const int vec = lane >> 2, pi = lane & 3;
            bf16_t* base = ur + (vec < 8 ? 2048 + vec * 64 : 2560 + (vec - 8) * 64) + (pi >> 1) * 32 + (pi & 1) * 8;
            const float pos = (float)((pi >> 1) ? (t & 63) : (t >> 6));
            const u32x4 z1 = *(const u32x4*)base, z2 = *(const u32x4*)(base + 16);
            float a1[8] = {bflo(z1.x), bfhi(z1.x), bflo(z1.y), bfhi(z1.y), bflo(z1.z), bfhi(z1.z), bflo(z1.w), bfhi(z1.w)};
            float a2[8] = {bflo(z2.x), bfhi(z2.x), bflo(z2.y), bfhi(z2.y), bflo(z2.z), bfhi(z2.z), bflo(z2.w), bfhi(z2.w)};
            float o1[8], o2[8];
#pragma unroll
            for (int j = 0; j < 8; ++j) {
                const float fi = (float)((pi & 1) * 8 + j);
                const float fr = __builtin_amdgcn_exp2f(-0.8304820237218406f * fi);
                float rev = pos * fr * 0.15915494309189535f; rev -= floorf(rev);
                const float sn = __builtin_amdgcn_sinf(rev), cs = __builtin_amdgcn_cosf(rev);
                o1[j] = a1[j] * cs - a2[j] * sn; o2[j] = a2[j] * cs + a1[j] * sn;
            }
            u32x4 w1, w2;
            w1.x = pk2(o1[0], o1[1]); w1.y = pk2(o1[2], o1[3]); w1.z = pk2(o1[4], o1[5]); w1.w = pk2(o1[6], o1[7]);
            w2.x = pk2(o2[0], o2[1]); w2.y = pk2(o2[2], o2[3]); w2.z = pk2(o2[4], o2[5]); w2.w = pk2(o2[6], o2[7]);
            *(u32x4*)base = w1; *(u32x4*)(base + 16) = w2;
        }
    }
}

constexpr int SC_W = 0, SC_KK = 8192, SC_BB = 16384, SC_KD = 24576, SC_R = 32768, SC_V = 40960, SC_KC = 49152, SC_TW = 57344, SC_TA = 57344 + 4608,
              SC_YS = 66560, SC_BON = 74752, SC_SHW = 75008, SC_RAW = 78848, SC_A = SC_RAW  ,
              SC_SF = 100608  , SC_SV = 116992  ,
              SC_SUB = 130304, SUB_BYTES = 15616  , SB_KRT = 0  , SB_BDT = 4608  ,
              SB_BH = 9216  , SB_MBK = 14336  , SB_G16 = 15360  ,
              SC_MM = SC_KC  , MM_BYTES = 3840, MM_MB1 = 0  , MM_MB2 = 1280  , MM_MBT = 2560  ;
static_assert(SC_SUB + 2 * SUB_BYTES <= 163072 && 2 * MM_BYTES <= 8192, "scan LDS map");
DI float sum16(float x) {
    x += dpp_f(x, 0); x += dpp_f(x, 1); x += dpp_f(x, 2);
    x += __builtin_bit_cast(float, __builtin_amdgcn_update_dpp(0, __builtin_bit_cast(int, x), 0x140, 0xF, 0xF, true));
    return x;
}
DI void scan_chunk_pos(int ch, int dir, int b, int& seg, int& c0, int& L, size_t& segrow) {
    if (ch < 8) { seg = 0; c0 = (dir ? 7 - ch : ch) * 32; } else { seg = 1; c0 = (dir ? 63 - (ch - 8) : ch - 8) * 32; }
    L = seg ? T : CT; segrow = seg ? (size_t)b * T : (size_t)ML + (size_t)b * CT;
}
DI void scan_issue_raw(const bf16_t* U, LAS unsigned char* lds, int chx, int dir, int b, int wave, const int (&pre)[3]) {
    int seg, c0, L; size_t segrow; scan_chunk_pos(chx, dir, b, seg, c0, L, segrow);
#pragma unroll
    for (int it = 0; it < 3; ++it) {
        if (pre[it] >= 0) {
            int p = c0 - 1 + (pre[it] & 255); p = p < 0 ? 0 : (p > L - 1 ? L - 1 : p);
            const bf16_t* gp = U + (segrow + p) * UP + (pre[it] >> 8);
            __builtin_amdgcn_global_load_lds((const unsigned*)gp, (LAS unsigned*)(lds + SC_RAW + (wave + 8 * it) * 1024), 16, 0, 0);
        }
    }
}
DI void scanA_item(LAS unsigned char* lds, int i, int chn, int c0, int L) {
                const int grp = chn >> 3, c8 = (chn & 7) * 8;
                const int p = c0 + i;
                const LAS unsigned char* rp = lds + SC_RAW + (i * 40 + chn) * 16;
                u32x4 pv = *(const LAS u32x4*)rp; const u32x4 cu = *(const LAS u32x4*)(rp + 640); u32x4 nx = *(const LAS u32x4*)(rp + 1280);
                if (p == 0) pv = (u32x4){0u, 0u, 0u, 0u};
                if (p == L - 1) nx = (u32x4){0u, 0u, 0u, 0u};
                const LAS float* sw = (const LAS float*)(lds + SC_SHW) + chn * 8;
                const f32x4 w0a = *(const LAS f32x4*)sw, w0b = *(const LAS f32x4*)(sw + 4);
                const f32x4 w1a = *(const LAS f32x4*)(sw + 320), w1b = *(const LAS f32x4*)(sw + 324);
                const f32x4 w2a = *(const LAS f32x4*)(sw + 640), w2b = *(const LAS f32x4*)(sw + 644);
                f32x4 va, vb;
                va.x = bflo(pv.x) * w0a.x + bflo(cu.x) * w1a.x + bflo(nx.x) * w2a.x;
                va.y = bfhi(pv.x) * w0a.y + bfhi(cu.x) * w1a.y + bfhi(nx.x) * w2a.y;
                va.z = bflo(pv.y) * w0a.z + bflo(cu.y) * w1a.z + bflo(nx.y) * w2a.z;
                va.w = bfhi(pv.y) * w0a.w + bfhi(cu.y) * w1a.w + bfhi(nx.y) * w2a.w;
                vb.x = bflo(pv.z) * w0b.x + bflo(cu.z) * w1b.x + bflo(nx.z) * w2b.x;
                vb.y = bfhi(pv.z) * w0b.y + bfhi(cu.z) * w1b.y + bfhi(nx.z) * w2b.y;
                vb.z = bflo(pv.w) * w0b.z + bflo(cu.w) * w1b.z + bflo(nx.w) * w2b.z;
                vb.w = bfhi(pv.w) * w0b.w + bfhi(cu.w) * w1b.w + bfhi(nx.w) * w2b.w;
                if (grp < 3) {
                    LAS float* dst = (LAS float*)(lds + (grp == 0 ? SC_R : (grp == 1 ? SC_KC : SC_V))) + i * 64 + c8;
                    *(LAS f32x4*)dst = va; *(LAS f32x4*)(dst + 4) = vb;
                } else {
                    if (grp == 3) {
#pragma unroll
                        for (int j = 0; j < 4; ++j) { va[j] = 1.f - 2.f * __builtin_amdgcn_rcpf(__builtin_amdgcn_exp2f(2.885390081777927f * va[j]) + 1.f);
                                                      vb[j] = 1.f - 2.f * __builtin_amdgcn_rcpf(__builtin_amdgcn_exp2f(2.885390081777927f * vb[j]) + 1.f); }
                    }
                    u32x4 w; w.x = pk2(va.x, va.y); w.y = pk2(va.z, va.w); w.z = pk2(vb.x, vb.y); w.w = pk2(vb.z, vb.w);
                    *(LAS u32x4*)(lds + (grp == 3 ? SC_TW : SC_TA) + (i * 72 + c8) * 2) = w;
                }
}
DI void scan_phase(const Args& a, LAS unsigned char* lds, int tid, int lane, int wave) {
    const bf16_t* U = (const bf16_t*)(a.ws + WS_U); bf16_t* Y = (bf16_t*)(a.ws + WS_Y); float* BON = (float*)(a.ws + WS_BON);
    const float* shw = a.in[11]; const float* w0p = a.in[12]; const float* w2p = a.in[13]; const float* a0p = a.in[14]; const float* a2p = a.in[15];
    const float* k_k = a.in[17]; const float* k_a = a.in[18]; const float* r_k = a.in[19];
    const int hh = lane >> 5, r32 = lane & 31;
    for (int item = blockIdx.x; item < 256; item += gridDim.x) {
        const int b = item >> 4, h = (item >> 1) & 7, dir = item & 1;
        int pre[3];
#pragma unroll
        for (int it = 0; it < 3; ++it) {
            const int j = wave + 8 * it, q = 64 * j + lane;
            if (j < 22 && q < 1360) { const int ts = q / 40, chn = q % 40, grp = chn >> 3, c8 = (chn & 7) * 8;
                pre[it] = ts | (((grp < 3 ? grp * 512 + h * 64 : (grp == 3 ? 1536 : 1664) + dir * 64) + c8) << 8); }
            else pre[it] = -1;
        }
        scan_issue_raw(U, lds, 0, dir, b, wave, pre);
        bf16x8 bfr[4];
        float bias0 = 0.f;
        {
            const int mat = wave & 1, nb = (wave >> 1) & 1;
            const float* Wl = (mat == 0 ? w2p : a2p) + (size_t)dir * 64 * 512 + h * 64;
#pragma unroll
            for (int ks = 0; ks < 4; ++ks) {
                float t8[8];
#pragma unroll
                for (int j = 0; j < 8; ++j) t8[j] = Wl[(size_t)(16 * ks + 8 * hh + j) * 512 + 32 * nb + r32];
                u32x4 w; w.x = pk2(t8[0], t8[1]); w.y = pk2(t8[2], t8[3]); w.z = pk2(t8[4], t8[5]); w.w = pk2(t8[6], t8[7]);
                bfr[ks] = __builtin_bit_cast(bf16x8, w);
            }
            bias0 = ((mat == 0 ? w0p : a0p) + dir * 512 + h * 64)[32 * nb + r32];
        }
        const int ci = tid >> 4, cq = tid & 15, ck4 = 4 * cq;
        const f32x4 kk4 = *(const f32x4*)(k_k + h * 64 + ck4), ka4 = *(const f32x4*)(k_a + h * 64 + ck4), rk4 = *(const f32x4*)(r_k + h * 64 + ck4);
        for (int idx = tid; idx < 960; idx += 512) { const int tap = idx / 320, cc = idx % 320, grp = cc >> 6;
            const int col = (grp < 3 ? grp * 512 + h * 64 : (grp == 3 ? 1536 : 1664) + dir * 64) + (cc & 63);
            *(LAS float*)(lds + SC_SHW + idx * 4) = shw[tap * 1920 + col]; }
        for (int idx = tid; idx < 4096; idx += 512) *(LAS float*)(lds + SC_SF + idx * 4) = 0.f;
        for (int idx = tid; idx < 13312 / 16; idx += 512) *(LAS u32x4*)(lds + SC_SV + idx * 16) = (u32x4){0u, 0u, 0u, 0u};
        asm volatile("s_waitcnt vmcnt(0)" ::: "memory");
        __syncthreads();
        for (int ch = 0; ch < 72; ++ch) {
            int seg, c0, L; size_t segrow; scan_chunk_pos(ch, dir, b, seg, c0, L, segrow);
#pragma unroll 1
            for (int item2 = tid; item2 < (ch == 0 ? 1280 : 768); item2 += 512) {
                int i, chn;
                if (item2 < 768) { i = item2 / 24; chn = item2 - 24 * i; } else { const int j = (item2 - 768) & 255; i = j >> 3; chn = (item2 < 1024 ? 24 : 32) + (j & 7); }
                scanA_item(lds, i, chn, c0, L);
            }
            __syncthreads();
            {
                const int mat = wave & 1, nb = (wave >> 1) & 1, half = wave >> 2;
                const LAS unsigned char* X = lds + (mat == 0 ? SC_TW : SC_TA);
                f32x16 acc0;
#pragma unroll
                for (int i = 0; i < 16; ++i) acc0[i] = 0.f;
#pragma unroll
                for (int ks = 0; ks < 4; ++ks) {
                    const bf16x8 af = *(const LAS bf16x8*)(X + (r32 * 72 + 16 * ks + 8 * hh) * 2);
                    acc0 = __builtin_amdgcn_mfma_f32_32x32x16_bf16(af, bfr[ks], acc0, 0, 0, 0);
                }
                LAS float* dst = (LAS float*)(lds + (mat == 0 ? SC_W : SC_A)) + 32 * nb + r32;
#pragma unroll
                for (int i8 = 0; i8 < 8; ++i8) {
                    const float av = half ? acc0[8 + i8] : acc0[i8];
                    float s0 = fast_sigmoid(av + bias0);
                    if (mat == 0) s0 = __builtin_amdgcn_exp2f(-0.8750612633917001f * s0);
                    dst[(crow(i8, hh) + 16 * half) * 64] = s0;
                }
            }
            __syncthreads();
            {
                const f32x4 kc = *(const LAS f32x4*)(lds + SC_KC + (ci * 64 + ck4) * 4);
                const f32x4 kkr = kc * kk4;
                float ss = (kkr.x * kkr.x + kkr.y * kkr.y) + (kkr.z * kkr.z + kkr.w * kkr.w);
                ss = sum16(ss);
                const f32x4 kk = kkr * rsqrtf(ss + 1e-12f);
                const f32x4 av = *(const LAS f32x4*)(lds + SC_A + (ci * 64 + ck4) * 4);
                const f32x4 bb = kk * av;
                const f32x4 kd = kc * (1.f + (av - 1.f) * ka4);
                const f32x4 rv = *(const LAS f32x4*)(lds + SC_R + (ci * 64 + ck4) * 4);
                const f32x4 pb = rv * kd * rk4;
                const float bon = sum16((pb.x + pb.y) + (pb.z + pb.w));
                *(LAS f32x4*)(lds + SC_KK + (ci * 64 + ck4) * 4) = kk;
                *(LAS f32x4*)(lds + SC_BB + (ci * 64 + ck4) * 4) = bb;
                *(LAS f32x4*)(lds + SC_KD + (ci * 64 + ck4) * 4) = kd;
                if (cq == 0) *(LAS float*)(lds + SC_BON + ci * 4) = bon;
            }
            __syncthreads();
            if (ch + 1 < 72) scan_issue_raw(U, lds, ch + 1, dir, b, wave, pre);
            {
                int tido = tid; asm volatile("" : "+v"(tido));
                const int ln = tido & 63, l15 = tido & 15, g4 = (tido >> 4) & 3;
                {
                    const int sub = wave >> 2, th = wave & 3, k = ln;
                    LAS unsigned char* sb = lds + SC_SUB + sub * SUB_BYTES;
                    float pg[17]; pg[0] = 1.f;
#pragma unroll
                    for (int st = 0; st < 16; ++st) {
                        const int tok = dir ? 31 - (16 * sub + st) : 16 * sub + st;
                        pg[st + 1] = pg[st] * *(const LAS float*)(lds + SC_W + (tok * 64 + k) * 4);
                    }
                    const float g = pg[16];
                    if (th == 0) *(LAS float*)(sb + SB_G16 + k * 4) = g;
#define SC_D_STEP(TT) do { const int t = (TT); const float gp = pg[TT], gc = pg[(TT) + 1]; \
                        const int tok = dir ? 31 - (16 * sub + t) : 16 * sub + t; \
                        const float kkv = *(const LAS float*)(lds + SC_KK + (tok * 64 + k) * 4), bbv = *(const LAS float*)(lds + SC_BB + (tok * 64 + k) * 4); \
                        const float kdv = *(const LAS float*)(lds + SC_KD + (tok * 64 + k) * 4), rv = *(const LAS float*)(lds + SC_R + (tok * 64 + k) * 4); \
                        const float ig = __builtin_amdgcn_rcpf(gc), bt = bbv * ig, dt = kdv * ig; \
                        *(LAS bf16_t*)(sb + SB_KRT + (t * 72 + k) * 2) = (bf16_t)(pk2(kkv * gp, 0.f) & 0xffffu); \
                        *(LAS bf16_t*)(sb + SB_KRT + ((16 + t) * 72 + k) * 2) = (bf16_t)(pk2(rv * gc, 0.f) & 0xffffu); \
                        *(LAS bf16_t*)(sb + SB_BDT + (t * 72 + k) * 2) = (bf16_t)(pk2(bt, 0.f) & 0xffffu); \
                        *(LAS bf16_t*)(sb + SB_BDT + ((16 + t) * 72 + k) * 2) = (bf16_t)(pk2(dt, 0.f) & 0xffffu); \
                        *(LAS bf16_t*)(sb + SB_BH + (k * 40 + 8 * (t >> 2) + (t & 3)) * 2) = (bf16_t)(pk2(bt * g, 0.f) & 0xffffu);         \
                        *(LAS bf16_t*)(sb + SB_BH + (k * 40 + 8 * (t >> 2) + 4 + (t & 3)) * 2) = (bf16_t)(pk2(dt * g, 0.f) & 0xffffu);     } while (0)
                    if (th == 0) { SC_D_STEP(0); SC_D_STEP(1); SC_D_STEP(2); SC_D_STEP(3); }
                    else if (th == 1) { SC_D_STEP(4); SC_D_STEP(5); SC_D_STEP(6); SC_D_STEP(7); }
                    else if (th == 2) { SC_D_STEP(8); SC_D_STEP(9); SC_D_STEP(10); SC_D_STEP(11); }
                    else { SC_D_STEP(12); SC_D_STEP(13); SC_D_STEP(14); SC_D_STEP(15); }
#undef SC_D_STEP
                }
                __syncthreads();
                {
                    const int sub = wave >> 2, wq = wave & 3, jb = wq >> 1, tb = wq & 1;
                    const LAS unsigned char* sb = lds + SC_SUB + sub * SUB_BYTES; LAS unsigned char* mm = lds + SC_MM + sub * MM_BYTES;
                    f32x4 acc = {0.f, 0.f, 0.f, 0.f};
#pragma unroll
                    for (int kb = 0; kb < 2; ++kb) {
                        const bf16x8 av = *(const LAS bf16x8*)(sb + SB_BDT + ((16 * jb + l15) * 72 + 32 * kb + 8 * g4) * 2);
                        const bf16x8 bv = *(const LAS bf16x8*)(sb + SB_KRT + ((16 * tb + l15) * 72 + 32 * kb + 8 * g4) * 2);
                        acc = __builtin_amdgcn_mfma_f32_16x16x32_bf16(av, bv, acc, 0, 0, 0);
                    }
                    const int t = l15;
#pragma unroll
                    for (int r = 0; r < 4; ++r) {
                        const int j = 4 * g4 + r;
                        const float mv = (tb == 0 ? (j < t) : (j <= t)) ? acc[r] : 0.f;
                        if (wq == 0) *(LAS float*)((LAS unsigned char*)sb + SB_MBK + (j * 16 + t) * 4) = mv;
                        else if (wq == 2) { *(LAS bf16_t*)(mm + MM_MB1 + (t * 40 + j) * 2) = (bf16_t)(pk2(mv, 0.f) & 0xffffu); *(LAS bf16_t*)(mm + MM_MB1 + (t * 40 + 16 + j) * 2) = 0; }
                        else if (wq == 1) *(LAS bf16_t*)(mm + MM_MB2 + (t * 40 + 8 * g4 + r) * 2) = (bf16_t)(pk2(mv, 0.f) & 0xffffu);
                        else *(LAS bf16_t*)(mm + MM_MB2 + (t * 40 + 8 * g4 + 4 + r) * 2) = (bf16_t)(pk2(mv, 0.f) & 0xffffu);
                    }
                }
                if ((wave & 3) == 0) {
                    const int sub = wave >> 2;
                    const LAS unsigned char* sb = lds + SC_SUB + sub * SUB_BYTES; LAS unsigned char* mm = lds + SC_MM + sub * MM_BYTES;
                    float acc[16];
#pragma unroll
                    for (int u = 0; u < 16; ++u) acc[u] = 0.f;
#pragma unroll
                    for (int t = 0; t < 16; ++t) {
                        const float sv = ((l15 == t) ? 1.f : 0.f) - acc[t];
                        if (ln < 16) { *(LAS bf16_t*)(mm + MM_MBT + (t * 40 + 8 * (ln >> 2) + (ln & 3)) * 2) = (bf16_t)(pk2(sv, 0.f) & 0xffffu);
                                       *(LAS bf16_t*)(mm + MM_MBT + (t * 40 + 8 * (ln >> 2) + 4 + (ln & 3)) * 2) = 0; }
#pragma unroll
                        for (int uq = 0; uq < 4; ++uq) {
                            if (4 * uq + 3 > t) {
                                const f32x4 m4 = *(const LAS f32x4*)(sb + SB_MBK + (t * 16 + 4 * uq) * 4);
#pragma unroll
                                for (int uu = 0; uu < 4; ++uu) if (4 * uq + uu > t) acc[4 * uq + uu] += sv * m4[uu];
                            }
                        }
                    }
                }
                asm volatile("s_waitcnt vmcnt(0)" ::: "memory");
                __syncthreads();
                if (wave >= 4) {
                    if (ch + 1 < 72) {
                        int segn, c0n, Ln; size_t segrown; scan_chunk_pos(ch + 1, dir, b, segn, c0n, Ln, segrown);
                        const int j = tid - 256;
                        scanA_item(lds, j >> 3, 24 + (j & 7), c0n, Ln);
                        scanA_item(lds, j >> 3, 32 + (j & 7), c0n, Ln);
                    }
                } else {
                    const int v = 16 * wave + l15;
                    const LAS unsigned char* svrow = lds + SC_SV + v * 208;
#pragma unroll 1
                    for (int sub = 0; sub < 2; ++sub) {
                        const LAS unsigned char* sb = lds + SC_SUB + sub * SUB_BYTES; const LAS unsigned char* mm = lds + SC_MM + sub * MM_BYTES;
                        u32x2 vc;
                        {
                            float vv[4];
#pragma unroll
                            for (int r = 0; r < 4; ++r) { const int tok = dir ? 31 - (16 * sub + 4 * g4 + r) : 16 * sub + 4 * g4 + r; vv[r] = *(const LAS float*)(lds + SC_V + (tok * 64 + v) * 4); }
                            vc.x = pk2(vv[0], vv[1]); vc.y = pk2(vv[2], vv[3]);
                            *(LAS u32x2*)((LAS unsigned char*)svrow + 128 + 8 * g4) = vc;
                        }
                        f32x4 acc = {0.f, 0.f, 0.f, 0.f};
#pragma unroll
                        for (int kb = 0; kb < 2; ++kb)
                            acc = __builtin_amdgcn_mfma_f32_16x16x32_bf16(*(const LAS bf16x8*)(sb + SB_KRT + (l15 * 72 + 32 * kb + 8 * g4) * 2), *(const LAS bf16x8*)(svrow + 64 * kb + 16 * g4), acc, 0, 0, 0);
                        acc = __builtin_amdgcn_mfma_f32_16x16x32_bf16(*(const LAS bf16x8*)(mm + MM_MB1 + (l15 * 40 + 8 * g4) * 2), *(const LAS bf16x8*)(svrow + 128 + 16 * g4), acc, 0, 0, 0);
                        u32x4 rb; rb.x = pk2(acc[0], acc[1]); rb.y = pk2(acc[2], acc[3]); rb.z = 0u; rb.w = 0u;
                        const f32x4 sa = __builtin_amdgcn_mfma_f32_16x16x32_bf16(*(const LAS bf16x8*)(mm + MM_MBT + (l15 * 40 + 8 * g4) * 2), __builtin_bit_cast(bf16x8, rb), (f32x4){0.f, 0.f, 0.f, 0.f}, 0, 0, 0);
                        u32x4 sb4; sb4.x = pk2(-sa[0], -sa[1]); sb4.y = pk2(-sa[2], -sa[3]); sb4.z = vc.x; sb4.w = vc.y;
                        const bf16x8 bop = __builtin_bit_cast(bf16x8, sb4);
                        f32x4 ya = {0.f, 0.f, 0.f, 0.f};
#pragma unroll
                        for (int kb = 0; kb < 2; ++kb)
                            ya = __builtin_amdgcn_mfma_f32_16x16x32_bf16(*(const LAS bf16x8*)(sb + SB_KRT + ((16 + l15) * 72 + 32 * kb + 8 * g4) * 2), *(const LAS bf16x8*)(svrow + 64 * kb + 16 * g4), ya, 0, 0, 0);
                        ya = __builtin_amdgcn_mfma_f32_16x16x32_bf16(*(const LAS bf16x8*)(mm + MM_MB2 + (l15 * 40 + 8 * g4) * 2), bop, ya, 0, 0, 0);
#pragma unroll
                        for (int r = 0; r < 4; ++r) { const int tok = dir ? 31 - (16 * sub + 4 * g4 + r) : 16 * sub + 4 * g4 + r; *(LAS float*)(lds + SC_YS + (tok * 64 + v) * 4) = ya[r]; }
#pragma unroll
                        for (int kt = 0; kt < 4; ++kt) {
                            const f32x4 dS = __builtin_amdgcn_mfma_f32_16x16x32_bf16(*(const LAS bf16x8*)(sb + SB_BH + ((16 * kt + l15) * 40 + 8 * g4) * 2), bop, (f32x4){0.f, 0.f, 0.f, 0.f}, 0, 0, 0);
                            const int k = 16 * kt + 4 * g4;
                            const f32x4 g16 = *(const LAS f32x4*)(sb + SB_G16 + k * 4);
                            const f32x4 sn = *(const LAS f32x4*)(lds + SC_SF + (v * 64 + k) * 4) * g16 + dS;
                            *(LAS f32x4*)(lds + SC_SF + (v * 64 + k) * 4) = sn;
                            u32x2 w; w.x = pk2(sn[0], sn[1]); w.y = pk2(sn[2], sn[3]);
                            *(LAS u32x2*)((LAS unsigned char*)svrow + k * 2) = w;
                        }
                    }
                }
            }
            asm volatile("s_waitcnt vmcnt(0)" ::: "memory");
            __syncthreads();
            if (seg) {
                const f32x4 yv = *(const LAS f32x4*)(lds + SC_YS + (ci * 64 + ck4) * 4);
                u32x2 o; o.x = pk2(yv.x, yv.y); o.y = pk2(yv.z, yv.w);
                *(u32x2*)(Y + ((size_t)dir * ML + (size_t)b * T + c0 + ci) * 512 + h * 64 + ck4) = o;
                if (tid < 32) BON[((size_t)dir * ML + (size_t)b * T + c0 + tid) * 8 + h] = *(const LAS float*)(lds + SC_BON + tid * 4);
            }
        }
        __syncthreads();
    }
}

DI s16x4 tr_read(const LAS unsigned char* p) { return __builtin_bit_cast(s16x4, __builtin_amdgcn_ds_read_tr16_b64_v4i16((LAS v4i16_t*)p)); }
DI void attn_phase(const Args& a, LAS unsigned char* lds, int tid, int lane, int wave) {
    const bf16_t* U = (const bf16_t*)(a.ws + WS_U); bf16_t* O = (bf16_t*)(a.ws + WS_O);
    const float* dl = a.in[22]; const float* subg = a.in[23];
    const float lam = __expf(wave_sum(dl[lane] * dl[64 + lane])) - __expf(wave_sum(dl[128 + lane] * dl[192 + lane])) + 0.2f;
    const int c = wave & 1, qblk = wave >> 1, hh = lane >> 5, r32 = lane & 31;
    constexpr int KP = 272, VP = 320, KBYTES = 64 * KP, STG = KBYTES + 64 * VP;
    constexpr float SCL = 0.125f * 1.4426950408889634f;
    const int i16 = lane & 15, q_ = i16 >> 2, p_ = i16 & 3, g_ = lane >> 4;
    for (int u0 = blockIdx.x; u0 < 1024; u0 += gridDim.x) {
        int u = u0;
        if (gridDim.x == 256) { const int j = u0 & 255, i = u0 >> 8; u = (j & 7) * 128 + i * 32 + (j >> 3); }
        const int b = u >> 6, h = (u >> 4) & 3, qb = u & 15;
        const size_t qrow = (size_t)b * T + qb * 128 + qblk * 32 + r32;
        bf16x8 qf[4];
#pragma unroll
        for (int ks = 0; ks < 4; ++ks) qf[ks] = *(const bf16x8*)(U + qrow * UP + 2048 + h * 128 + c * 64 + 16 * ks + 8 * hh);
        f32x16 o[4];
#pragma unroll
        for (int eb = 0; eb < 4; ++eb)
#pragma unroll
            for (int i = 0; i < 16; ++i) o[eb][i] = 0.f;
        float m_used = -1e30f, l = 0.f;
        const int skey0 = tid >> 4, sch = tid & 15;
        u32x4 rk0, rk1, rv0, rv1;
        const bf16_t* kp = U + ((size_t)ML + (size_t)b * CT + skey0) * UP + h * 128 + sch * 8;
        const bf16_t* const kp_lat = U + ((size_t)b * T + skey0) * UP + h * 128 + sch * 8;
#define ATT_LOAD(tt) do { \
            rk0 = *(const u32x4*)(kp + 2560); rv0 = *(const u32x4*)(kp + 3072); \
            rk1 = *(const u32x4*)(kp + 32 * UP + 2560); rv1 = *(const u32x4*)(kp + 32 * UP + 3072); \
            kp = ((tt) == 3) ? kp_lat : kp + 64 * UP; } while (0)
#define ATT_STORE(buf) do { \
            LAS unsigned char* kb_ = lds + (buf) * STG; LAS unsigned char* vb_ = kb_ + KBYTES; \
            *(LAS u32x4*)(kb_ + skey0 * KP + sch * 16) = rk0; *(LAS u32x4*)(kb_ + (skey0 + 32) * KP + sch * 16) = rk1; \
            *(LAS u32x4*)(vb_ + skey0 * VP + sch * 16) = rv0; *(LAS u32x4*)(vb_ + (skey0 + 32) * VP + sch * 16) = rv1; } while (0)
        ATT_LOAD(0); ATT_STORE(0);
        __syncthreads();
        for (int t = 0; t < 36; ++t) {
            if (t + 1 < 36) ATT_LOAD(t + 1);
            const LAS unsigned char* Kt = lds + (t & 1) * STG; const LAS unsigned char* Vt = Kt + KBYTES;
            f32x16 s0, s1;
#pragma unroll
            for (int i = 0; i < 16; ++i) { s0[i] = 0.f; s1[i] = 0.f; }
#pragma unroll
            for (int ks = 0; ks < 4; ++ks) {
                const bf16x8 k0 = *(const LAS bf16x8*)(Kt + r32 * KP + (c * 64 + 16 * ks + 8 * hh) * 2);
                const bf16x8 k1 = *(const LAS bf16x8*)(Kt + (32 + r32) * KP + (c * 64 + 16 * ks + 8 * hh) * 2);
                s0 = __builtin_amdgcn_mfma_f32_32x32x16_bf16(k0, qf[ks], s0, 0, 0, 0);
                s1 = __builtin_amdgcn_mfma_f32_32x32x16_bf16(k1, qf[ks], s1, 0, 0, 0);
            }
            float tmax = fmaxf(s0[0], s1[0]), tmax2 = fmaxf(s0[1], s1[1]);
#pragma unroll
            for (int i = 2; i < 16; i += 2) { tmax = max3_s(tmax, s0[i], s1[i]); tmax2 = max3_s(tmax2, s0[i + 1], s1[i + 1]); }
            tmax = fmaxf(tmax, tmax2);
            tmax = fmaxf(tmax, __shfl_xor(tmax, 32));
            const float tm = tmax * SCL;
            if (__any(tm > m_used + 8.f)) {
                const float mn = fmaxf(m_used, tm);
                const float al = __builtin_amdgcn_exp2f(m_used - mn);
#pragma unroll
                for (int eb = 0; eb < 4; ++eb) o[eb] = o[eb] * al;
                l *= al; m_used = mn;
            }
            bf16x8 pf[2][2];
            {
                float p0[16], p1[16];
#pragma unroll
                for (int i = 0; i < 16; ++i) { p0[i] = __builtin_amdgcn_exp2f(__builtin_fmaf(s0[i], SCL, -m_used)); p1[i] = __builtin_amdgcn_exp2f(__builtin_fmaf(s1[i], SCL, -m_used)); l += p0[i] + p1[i]; }
#pragma unroll
                for (int s = 0; s < 2; ++s) {
                    u32x4 w0, w1;
                    w0.x = pk2(p0[8 * s + 0], p0[8 * s + 1]); w0.y = pk2(p0[8 * s + 2], p0[8 * s + 3]); w0.z = pk2(p0[8 * s + 4], p0[8 * s + 5]); w0.w = pk2(p0[8 * s + 6], p0[8 * s + 7]);
                    w1.x = pk2(p1[8 * s + 0], p1[8 * s + 1]); w1.y = pk2(p1[8 * s + 2], p1[8 * s + 3]); w1.z = pk2(p1[8 * s + 4], p1[8 * s + 5]); w1.w = pk2(p1[8 * s + 6], p1[8 * s + 7]);
                    pf[0][s] = __builtin_bit_cast(bf16x8, w0); pf[1][s] = __builtin_bit_cast(bf16x8, w1);
                }
            }
#pragma unroll
            for (int kb = 0; kb < 2; ++kb)
#pragma unroll
                for (int s = 0; s < 2; ++s)
#pragma unroll
                    for (int eb = 0; eb < 4; ++eb) {
                        const LAS unsigned char* vb = Vt + (32 * kb + 16 * s + 4 * hh + q_) * VP + (32 * eb + 16 * (g_ & 1) + 4 * p_) * 2;
                        const s16x4 lo = tr_read(vb), hi = tr_read(vb + 8 * VP);
                        const bf16x8 vf = {lo[0], lo[1], lo[2], lo[3], hi[0], hi[1], hi[2], hi[3]};
                        o[eb] = __builtin_amdgcn_mfma_f32_32x32x16_bf16(vf, pf[kb][s], o[eb], 0, 0, 0);
                    }
            if (t + 1 < 36) ATT_STORE((t + 1) & 1);
            __syncthreads();
        }
#undef ATT_LOAD
#undef ATT_STORE
        l += __shfl_xor(l, 32);
        const float inv = 1.f / l;
        LAS float* XO = (LAS float*)lds + qblk * 4096;
        if (c == 1) {
            const float sc = inv * lam;
#pragma unroll
            for (int eb = 0; eb < 4; ++eb)
#pragma unroll
                for (int i = 0; i < 16; ++i) XO[(32 * eb + crow(i, hh)) * 32 + r32] = o[eb][i] * sc;
        }
        __syncthreads();
        if (c == 0) {
            float ss = 0.f;
#pragma unroll
            for (int eb = 0; eb < 4; ++eb)
#pragma unroll
                for (int i = 0; i < 16; ++i) { const float vv = o[eb][i] * inv - XO[(32 * eb + crow(i, hh)) * 32 + r32]; o[eb][i] = vv; ss += vv * vv; }
            ss += __shfl_xor(ss, 32);
            const float rstd = rsqrtf(ss * (1.f / 128.f) + EPS) * 0.8f;
#pragma unroll
            for (int eb = 0; eb < 4; ++eb)
#pragma unroll
                for (int g4 = 0; g4 < 4; ++g4) {
                    const int e0 = 32 * eb + 8 * g4 + 4 * hh;
                    const f32x4 sg = *(const f32x4*)(subg + e0);
                    u32x2 w; w.x = pk2(o[eb][4 * g4 + 0] * rstd * sg.x, o[eb][4 * g4 + 1] * rstd * sg.y); w.y = pk2(o[eb][4 * g4 + 2] * rstd * sg.z, o[eb][4 * g4 + 3] * rstd * sg.w);
                    *(u32x2*)(O + qrow * 512 + h * 128 + e0) = w;
                }
        }
        __syncthreads();
    }
}

DI void readout_phase(const Args& a, int lane, int wave) {
    const bf16_t* U = (const bf16_t*)(a.ws + WS_U); bf16_t* Y = (bf16_t*)(a.ws + WS_Y); const float* BON = (const float*)(a.ws + WS_BON); const bf16_t* Gb = (const bf16_t*)(a.ws + WS_G);
    const float* shw = a.in[11]; const float* lng = a.in[20]; const float* lnb = a.in[21];
    const int gw = blockIdx.x * 8 + wave, NGW = gridDim.x * 8;
    const int c8 = 8 * lane, head = lane >> 3;
    int r0, r1; wave_rows(ML, gw, NGW, r0, r1);
    if (r0 >= r1) return;
    const float* sw = shw + 1024 + c8;
    const f32x4 w0a = *(const f32x4*)sw, w0b = *(const f32x4*)(sw + 4), w1a = *(const f32x4*)(sw + 1920), w1b = *(const f32x4*)(sw + 1924), w2a = *(const f32x4*)(sw + 3840), w2b = *(const f32x4*)(sw + 3844);
    const f32x4 lga = *(const f32x4*)(lng + c8), lgb = *(const f32x4*)(lng + c8 + 4), lba = *(const f32x4*)(lnb + c8), lbb = *(const f32x4*)(lnb + c8 + 4);
    const float lg[8] = {lga.x, lga.y, lga.z, lga.w, lgb.x, lgb.y, lgb.z, lgb.w}, lb[8] = {lba.x, lba.y, lba.z, lba.w, lbb.x, lbb.y, lbb.z, lbb.w};
    const u32x4 z4 = {0u, 0u, 0u, 0u};
    const bf16_t* ub = U + 1024 + c8;
    u32x4 pv = (r0 > 0) ? *(const u32x4*)(ub + (size_t)(r0 - 1) * UP) : z4;
    u32x4 cu = *(const u32x4*)(ub + (size_t)r0 * UP);
    u32x4 nx = (r0 + 1 < ML) ? *(const u32x4*)(ub + (size_t)(r0 + 1) * UP) : z4;
    u32x4 yf = *(const u32x4*)(Y + (size_t)r0 * 512 + c8), yb = *(const u32x4*)(Y + ((size_t)ML + r0) * 512 + c8), gr = *(const u32x4*)(Gb + (size_t)r0 * 512 + c8);
    float bonus = BON[(size_t)r0 * 8 + head] + BON[((size_t)ML + r0) * 8 + head];
    for (int row = r0; row < r1; ++row) {
        u32x4 nyf = z4, nyb = z4, ngr = z4, nnx = z4; float nbonus = 0.f;
        if (row + 1 < r1) {
            const int rn = row + 1;
            nyf = *(const u32x4*)(Y + (size_t)rn * 512 + c8); nyb = *(const u32x4*)(Y + ((size_t)ML + rn) * 512 + c8); ngr = *(const u32x4*)(Gb + (size_t)rn * 512 + c8);
            nbonus = BON[(size_t)rn * 8 + head] + BON[((size_t)ML + rn) * 8 + head];
            if (rn + 1 < ML) nnx = *(const u32x4*)(ub + (size_t)(rn + 1) * UP);
        }
        float y[8] = {bflo(yf.x) + bflo(yb.x), bfhi(yf.x) + bfhi(yb.x), bflo(yf.y) + bflo(yb.y), bfhi(yf.y) + bfhi(yb.y),
                      bflo(yf.z) + bflo(yb.z), bfhi(yf.z) + bfhi(yb.z), bflo(yf.w) + bflo(yb.w), bfhi(yf.w) + bfhi(yb.w)};
        float sm = 0.f;
#pragma unroll
        for (int j = 0; j < 8; ++j) sm += y[j];
        const float mu = sum8(sm) * (1.f / 64.f);
        float q = 0.f;
#pragma unroll
        for (int j = 0; j < 8; ++j) { y[j] -= mu; q += y[j] * y[j]; }
        const float rstd = rsqrtf(sum8(q) * (1.f / 64.f) + 64e-5f);
        const bool first = (row & (T - 1)) == 0, last = (row & (T - 1)) == T - 1;
        const u32x4 pvv = first ? z4 : pv, nxv = last ? z4 : nx;
        float vc[8];
        vc[0] = bflo(pvv.x) * w0a.x + bflo(cu.x) * w1a.x + bflo(nxv.x) * w2a.x;
        vc[1] = bfhi(pvv.x) * w0a.y + bfhi(cu.x) * w1a.y + bfhi(nxv.x) * w2a.y;
        vc[2] = bflo(pvv.y) * w0a.z + bflo(cu.y) * w1a.z + bflo(nxv.y) * w2a.z;
        vc[3] = bfhi(pvv.y) * w0a.w + bfhi(cu.y) * w1a.w + bfhi(nxv.y) * w2a.w;
        vc[4] = bflo(pvv.z) * w0b.x + bflo(cu.z) * w1b.x + bflo(nxv.z) * w2b.x;
        vc[5] = bfhi(pvv.z) * w0b.y + bfhi(cu.z) * w1b.y + bfhi(nxv.z) * w2b.y;
        vc[6] = bflo(pvv.w) * w0b.z + bflo(cu.w) * w1b.z + bflo(nxv.w) * w2b.z;
        vc[7] = bfhi(pvv.w) * w0b.w + bfhi(cu.w) * w1b.w + bfhi(nxv.w) * w2b.w;
        const float gv[8] = {bflo(gr.x), bfhi(gr.x), bflo(gr.y), bfhi(gr.y), bflo(gr.z), bfhi(gr.z), bflo(gr.w), bfhi(gr.w)};
        float ov[8];
#pragma unroll
        for (int j = 0; j < 8; ++j) ov[j] = (y[j] * rstd * lg[j] + lb[j] + bonus * vc[j]) * gv[j];
        u32x4 w; w.x = pk2(ov[0], ov[1]); w.y = pk2(ov[2], ov[3]); w.z = pk2(ov[4], ov[5]); w.w = pk2(ov[6], ov[7]);
        *(u32x4*)(Y + (size_t)row * 512 + c8) = w;
        pv = cu; cu = nx; nx = nnx; yf = nyf; yb = nyb; gr = ngr; bonus = nbonus;
    }
}

#define XB_TMO      128
#define XB_XCNT(j)  (256  + 64 * (j))
#define XB_XSUB(j)  (1280 + 64 * (j))
#define XB_XGEN(j)  (2304 + 64 * (j))
#define XB_TOP      3328
#define XB_TOPGEN   3392
#define XCD_BAR_WORDS 3456
#define XB_SPIN_CAP (1u << 18)

__device__ __forceinline__ unsigned xb_ld(unsigned* p)              { return __hip_atomic_load(p, __ATOMIC_RELAXED, __HIP_MEMORY_SCOPE_AGENT); }
__device__ __forceinline__ unsigned xb_add(unsigned* p, unsigned v) { return __hip_atomic_fetch_add(p, v, __ATOMIC_RELAXED, __HIP_MEMORY_SCOPE_AGENT); }
__device__ __forceinline__ unsigned xb_xcc_id() { return (unsigned)__builtin_amdgcn_s_getreg((3 << 11) | 20) & 0xFu; }
#define XB_SPIN(cond, bar) do { unsigned _sp = 0; while (cond) { __builtin_amdgcn_s_sleep(1); \
    if ((++_sp & 255u) == 0u) { if (xb_ld(&(bar)[XB_TMO])) break; if (_sp > XB_SPIN_CAP) { atomicAdd(&(bar)[XB_TMO], 1u); break; } } } } while (0)

struct XcdBarrier {
    unsigned* bar; unsigned x;
    volatile LAS unsigned* st;
};

__device__ __forceinline__ XcdBarrier xcd_barrier_post(unsigned* bar, volatile LAS unsigned* st) {
    XcdBarrier b; b.bar = bar; b.x = xb_xcc_id(); b.st = st;
    if (threadIdx.x == 0) (void)xb_add(&bar[XB_XCNT(b.x)], 1u);
    return b;
}
__device__ __forceinline__ void xcd_barrier_complete(unsigned* bar, unsigned x, unsigned& nloc, unsigned& nx) {
    const unsigned G = gridDim.x * gridDim.y * gridDim.z;
    unsigned sum, cnt, mine, sp = 0u;
    for (;;) {
        sum = 0u; cnt = 0u; mine = 0u;
#pragma unroll
        for (unsigned j = 0; j < 16; ++j) { const unsigned c = xb_ld(&bar[XB_XCNT(j)]); sum += c; cnt += (c > 0u) ? 1u : 0u; mine = (j == x) ? c : mine; }
        if (sum == G) break;
        __builtin_amdgcn_s_sleep(1);
        if ((++sp & 255u) == 0u) { if (xb_ld(&bar[XB_TMO])) break; if (sp > XB_SPIN_CAP) { atomicAdd(&bar[XB_TMO], 1u); break; } }
    }
    nloc = mine > 0u ? mine : 1u; nx = cnt > 0u ? cnt : 1u;
}

__device__ __forceinline__ void xcd_barrier(const XcdBarrier& b) {
    asm volatile("s_waitcnt vmcnt(0)" ::: "memory");
    __syncthreads();
    if (threadIdx.x == 0) {
        unsigned* bar = b.bar;
        __builtin_amdgcn_s_waitcnt(0);
        unsigned nloc = b.st[0], nx = b.st[1];
        if (nloc == 0u) { xcd_barrier_complete(bar, b.x, nloc, nx); b.st[0] = nloc; b.st[1] = nx; }
        const unsigned old = xb_add(&bar[XB_XSUB(b.x)], 1u);
        const unsigned gen = old / nloc;
        if (old + 1u == (gen + 1u) * nloc) {
            __builtin_amdgcn_fence(__ATOMIC_RELEASE, "agent");
            asm volatile("s_waitcnt vmcnt(0)" ::: "memory");
            const unsigned og = xb_add(&bar[XB_TOP], 1u);
            const unsigned tg = og / nx;
            if (og + 1u == (tg + 1u) * nx) xb_add(&bar[XB_TOPGEN], 1u);
            else XB_SPIN(xb_ld(&bar[XB_TOPGEN]) == tg, bar);
            __builtin_amdgcn_fence(__ATOMIC_ACQUIRE, "agent");
            xb_add(&bar[XB_XGEN(b.x)], 1u);
            asm volatile("s_waitcnt vmcnt(0)" ::: "memory");
        } else {
            XB_SPIN(xb_ld(&bar[XB_XGEN(b.x)]) == gen, bar);
            __builtin_amdgcn_fence(__ATOMIC_ACQUIRE, "agent");
            asm volatile("s_waitcnt vmcnt(0)" ::: "memory");
        }
    }
    __syncthreads();
}

__global__ void __launch_bounds__(512, 2) mk_fwd(Args a) {
    extern __shared__ __attribute__((aligned(16))) unsigned char lds_raw[];
    cg::grid_group grid = cg::this_grid();
    LAS unsigned char* lds = (LAS unsigned char*)lds_raw;
    const int tid = threadIdx.x, lane = tid & 63, wave = __builtin_amdgcn_readfirstlane(tid >> 6);
    unsigned char* ws = a.ws;
    const int gw = blockIdx.x * 8 + wave, NGW = gridDim.x * 8;
    const float* MOD = (const float*)(ws + WS_MOD);
    const float* preg = a.in[6]; const float* postg = a.in[7];
    bf16_t* H = (bf16_t*)(ws + WS_H);
    const int lo = a.ph_lo & 0xff, hi = a.ph_hi;
    if (tid < 2) *(volatile LAS unsigned*)(lds + LDS_BARST + 4 * tid) = 0u;
    __syncthreads();
    const XcdBarrier xbar = xcd_barrier_post((unsigned*)(ws + WS_BAR), (volatile LAS unsigned*)(lds + LDS_BARST));
#define IN(k) (lo <= (k) && (k) < hi)
#define SEAM(k) do { if (IN(k) && IN((k) + 1)) xcd_barrier(xbar); } while (0)
    if (hi > 4096) grid.sync();

#ifndef NO_P0
    if (IN(0)) p0_phase(a, lds, tid, lane, wave);
#endif
    SEAM(0);
#pragma unroll 1
    for (int rsy = 0; rsy < ((a.ph_lo >> 16) & 63); ++rsy) xcd_barrier(xbar);
    if (IN(1)) {
        int r0, r1;
        wave_rows(ML, gw, NGW, r0, r1);
        rowpass_block<false, false, true, false, false>(r0, r1, a.in[0], nullptr, nullptr, MOD, -1, 0, 0.f, nullptr, preg, 0, 1024, H, lane);
        wave_rows(MC, gw, NGW, r0, r1);
        rowpass_block<false, false, true, false, false>(r0, r1, a.in[2], nullptr, nullptr, MOD, 16, 0, 0.f, nullptr, preg, 0, 1024, H + (size_t)ML * D, lane);
    }
    SEAM(1);
    if (IN(2)) run_gemm<1>(lds, H, (const bf16_t*)(ws + WS_W1IN), MA, 2 * DFF, D, (bf16_t*)(ws + WS_ACT), DFF, nullptr, 0);
    SEAM(2);
    bf16_t* const X1 = (bf16_t*)a.out;
    bf16_t* const X2 = (bf16_t*)(ws + WS_Y);
    const bool split3 = gridDim.x > 64;
    if (IN(3)) {
        const bf16_t* F = (const bf16_t*)(ws + WS_F);
        run_gemm<0>(lds, (const bf16_t*)(ws + WS_ACT), (const bf16_t*)(ws + WS_W1OUT), ML, D, DFF, (bf16_t*)(ws + WS_F), D, nullptr, 0);
        xcd_barrier(xbar);
        run_gemm<0>(lds, (const bf16_t*)(ws + WS_ACT) + (size_t)ML * DFF, (const bf16_t*)(ws + WS_W1OUT), MC, D, DFF, (bf16_t*)(ws + WS_F) + (size_t)ML * D, D, nullptr, 0);
        if (split3 && blockIdx.x >= 64) {
            const int gw3 = ((int)blockIdx.x - 64) * 8 + wave, NGW3 = ((int)gridDim.x - 64) * 8;
            int r0, r1; wave_rows(ML, gw3, NGW3, r0, r1);
            rowpass_block<true, true, true, false, true>(r0, r1, a.in[0], F, postg, MOD, -1, 2048, 0.5f, X1, preg + 1024, 3072, 4096, H, lane);
        }
    }
    SEAM(3);
    if (IN(4)) {
        const bf16_t* F = (const bf16_t*)(ws + WS_F);
        int r0, r1;
        if (!split3) { wave_rows(ML, gw, NGW, r0, r1); rowpass_block<true, true, true, false, true>(r0, r1, a.in[0], F, postg, MOD, -1, 2048, 0.5f, X1, preg + 1024, 3072, 4096, H, lane); }
        wave_rows(MC, gw, NGW, r0, r1);
        rowpass_block<true, false, true, false, false>(r0, r1, a.in[2], F + (size_t)ML * D, postg, MOD, 16, 2048, 0.5f, nullptr, preg + 1024, 3072, 4096, H + (size_t)ML * D, lane);
    }
    SEAM(4);
    if (IN(5)) run_gemm<0>(lds, H, (const bf16_t*)(ws + WS_WMIX), MA, UP, D, (bf16_t*)(ws + WS_U), UP, nullptr, 0);
    SEAM(5);
#ifndef NO_PREP
    if (IN(6)) prep_phase(a, lane, wave);
#endif
    SEAM(6);
    if (IN(7)) {
#ifndef NO_SCAN
#pragma unroll 1
        for (int rep = 0; rep <= ((a.ph_lo >> 8) & 3); ++rep) scan_phase(a, lds, tid, lane, wave);
#endif
#ifndef NO_ATTN
#pragma unroll 1
        for (int rep = 0; rep <= ((a.ph_lo >> 10) & 3); ++rep) attn_phase(a, lds, tid, lane, wave);
#endif
        run_gemm<0>(lds, (const bf16_t*)(ws + WS_AG), (const bf16_t*)(ws + WS_WG2), ML, 512, 256, (bf16_t*)(ws + WS_G), 512, nullptr, 0);
    }
    SEAM(7);
#ifndef NO_READ
    if (IN(8)) readout_phase(a, lane, wave);
#endif
    SEAM(8);
    if (IN(9)) run_gemm<2>(lds, H, (const bf16_t*)(ws + WS_WMIX) + (size_t)UP * D, ML, 2048, D, (bf16_t*)(ws + WS_UG), 2048, nullptr, 0);
    SEAM(9);
    if (IN(10)) {
        run_gemm<3>(lds, (const bf16_t*)(ws + WS_Y), (const bf16_t*)(ws + WS_WUPA), ML, D, 512, (bf16_t*)(ws + WS_MG), D, (const bf16_t*)(ws + WS_UG), 2048);
        run_gemm<4>(lds, (const bf16_t*)(ws + WS_O), (const bf16_t*)(ws + WS_WUPB), ML, D, 512, (bf16_t*)(ws + WS_MG), D, (const bf16_t*)(ws + WS_UG), 2048);
    }
    SEAM(10);
    if (IN(11)) run_gemm<0>(lds, (const bf16_t*)(ws + WS_MG), (const bf16_t*)(ws + WS_WOUT), ML, D, D, (bf16_t*)(ws + WS_F2), D, nullptr, 0);
    SEAM(11);
    if (IN(12)) {
        const bf16_t* F = (const bf16_t*)(ws + WS_F2); bf16_t* H3 = (bf16_t*)(ws + WS_H3);
        int r0, r1; wave_rows(ML, gw, NGW, r0, r1);
        rowpass_block<true, true, true, true, true>(r0, r1, X1, F, postg + 1024, MOD, -1, 5120, 1.0f, X2, preg + 2048, 6144, 7168, H3, lane);
    }
    SEAM(12);
    if (IN(13)) run_gemm<1>(lds, (const bf16_t*)(ws + WS_H3), (const bf16_t*)(ws + WS_W2IN), ML, 2 * DFF, D, (bf16_t*)(ws + WS_ACT2), DFF, nullptr, 0);
    SEAM(13);
    if (IN(14)) run_gemm<0>(lds, (const bf16_t*)(ws + WS_ACT2), (const bf16_t*)(ws + WS_W2OUT), ML, D, DFF, (bf16_t*)(ws + WS_F2), D, nullptr, 0);
    SEAM(14);
    if (IN(15)) {
        const bf16_t* F = (const bf16_t*)(ws + WS_F2);
        int r0, r1; wave_rows(ML, gw, NGW, r0, r1);
        rowpass_block<true, true, false, true, false>(r0, r1, X2, F, postg + 2048, MOD, -1, 8192, 0.5f, a.out, nullptr, 0, 0, nullptr, lane);
    }
}

extern "C" void kernel_launch(void* const* d_in, const int* in_sizes, int n_in, void* d_out, int out_size, void* d_ws, size_t ws_size, hipStream_t stream) {
    static int grid = 0;
    if (grid == 0) {
        if (n_in != 29 || ws_size < WS_END) { fprintf(stderr, "kernel_launch: unexpected n_in %d / ws %zu\n", n_in, ws_size); grid = -1; return; }
        int dev = 0, cus = 0, per_cu = 0;
        hipGetDevice(&dev);
        hipDeviceGetAttribute(&cus, hipDeviceAttributeMultiprocessorCount, dev);
        hipFuncSetAttribute((const void*)mk_fwd, hipFuncAttributeMaxDynamicSharedMemorySize, LDS_BYTES);
        hipOccupancyMaxActiveBlocksPerMultiprocessor(&per_cu, (const void*)mk_fwd, 512, LDS_BYTES);
        (void)hipGetLastError();
        if (per_cu < 1) { fprintf(stderr, "kernel_launch: occupancy query says %d blocks per CU\n", per_cu); per_cu = 1; }
        grid = cus;
    }
    if (grid < 0) return;
    if (hipMemsetAsync((char*)d_ws + WS_BAR, 0, 16384, stream) != hipSuccess) { fprintf(stderr, "kernel_launch: memset of barrier words failed\n"); return; }
    Args a{};
    for (int i = 0; i < 29; ++i) a.in[i] = (const float*)d_in[i];
    a.out = (float*)d_out; a.ws = (unsigned char*)d_ws; a.ph_lo = PROBE_BITS; a.ph_hi = 16;
    void* args[] = {&a};
    hipError_t e = hipLaunchCooperativeKernel((const void*)mk_fwd, dim3(grid), dim3(512), args, LDS_BYTES, stream);
    if (e != hipSuccess) fprintf(stderr, "cooperative launch failed: %s (grid %d)\n", hipGetErrorString(e), grid);
}
```

```cpp
#include <hip/hip_runtime.h>
#include <hip/hip_cooperative_groups.h>
#include <cstdio>
#include <cstdint>
namespace cg = cooperative_groups;

typedef unsigned short bf16_t;
typedef short bf16x8 __attribute__((ext_vector_type(8)));
typedef short s16x4 __attribute__((ext_vector_type(4)));
typedef float f32x2 __attribute__((ext_vector_type(2)));
typedef float f32x4 __attribute__((ext_vector_type(4)));
typedef float f32x16 __attribute__((ext_vector_type(16)));
typedef unsigned u32x2 __attribute__((ext_vector_type(2)));
typedef unsigned u32x4 __attribute__((ext_vector_type(4)));
typedef __bf16 bf16x2_t __attribute__((ext_vector_type(2)));
typedef short v4i16_t __attribute__((ext_vector_type(4)));
#define LAS __attribute__((address_space(3)))
#define DI __device__ __forceinline__

DI unsigned pk2(float lo, float hi) { f32x2 v = {lo, hi}; bf16x2_t b = __builtin_convertvector(v, bf16x2_t); return __builtin_bit_cast(unsigned, b); }
DI float bflo(unsigned u) { return __builtin_bit_cast(float, u << 16); }
DI float bfhi(unsigned u) { return __builtin_bit_cast(float, u & 0xffff0000u); }
DI float wave_sum(float v) {
    v += __builtin_bit_cast(float, __builtin_amdgcn_update_dpp(0, __builtin_bit_cast(int, v), 0xB1, 0xF, 0xF, true));
    v += __builtin_bit_cast(float, __builtin_amdgcn_update_dpp(0, __builtin_bit_cast(int, v), 0x4E, 0xF, 0xF, true));
    v += __builtin_bit_cast(float, __builtin_amdgcn_update_dpp(0, __builtin_bit_cast(int, v), 0x141, 0xF, 0xF, true));
    v += __builtin_bit_cast(float, __builtin_amdgcn_update_dpp(0, __builtin_bit_cast(int, v), 0x140, 0xF, 0xF, true));
    const int vi = __builtin_bit_cast(int, v);
    const float r0 = __builtin_bit_cast(float, __builtin_amdgcn_readlane(vi, 0)), r1 = __builtin_bit_cast(float, __builtin_amdgcn_readlane(vi, 16));
    const float r2 = __builtin_bit_cast(float, __builtin_amdgcn_readlane(vi, 32)), r3 = __builtin_bit_cast(float, __builtin_amdgcn_readlane(vi, 48));
    return (r0 + r1) + (r2 + r3);
}
DI float dpp_f(float x, const int ctrl_sel) {
    int xi = __builtin_bit_cast(int, x);
    int r;
    if (ctrl_sel == 0) r = __builtin_amdgcn_update_dpp(0, xi, 0xB1, 0xF, 0xF, true);
    else if (ctrl_sel == 1) r = __builtin_amdgcn_update_dpp(0, xi, 0x4E, 0xF, 0xF, true);
    else r = __builtin_amdgcn_update_dpp(0, xi, 0x141, 0xF, 0xF, true);
    return __builtin_bit_cast(float, r);
}
DI float sum8(float x) { x += dpp_f(x, 0); x += dpp_f(x, 1); x += dpp_f(x, 2); return x; }
DI float fast_sigmoid(float x) { return __builtin_amdgcn_rcpf(1.f + __builtin_amdgcn_exp2f(-1.4426950408889634f * x)); }
DI float fma_s(float a, float b, float c) { float d; asm("v_fma_f32 %0, %1, %2, %3" : "=v"(d) : "v"(a), "v"(b), "v"(c)); return d; }
DI float nfma_s(float a, float b, float c) { float d; asm("v_fma_f32 %0, -%1, %2, %3" : "=v"(d) : "v"(a), "v"(b), "v"(c)); return d; }
DI float mul_s(float a, float b) { float d; asm("v_mul_f32_e32 %0, %1, %2" : "=v"(d) : "v"(a), "v"(b)); return d; }
DI float max3_s(float a, float b, float c) { float d; asm("v_max3_f32 %0, %1, %2, %3" : "=v"(d) : "v"(a), "v"(b), "v"(c)); return d; }
DI int crow(int r, int hi) { return (r & 3) + 8 * (r >> 2) + 4 * hi; }

constexpr int D = 1024, NB = 16, T = 2048, CT = 256, DFF = 2816;
constexpr int ML = NB * T;
constexpr int MC = NB * CT;
constexpr int MA = ML + MC;
constexpr int UP = 3584;
constexpr float EPS = 1e-6f;
constexpr size_t MiB = 1u << 20;
constexpr size_t WS_MOD = 0;
constexpr size_t WS_W1IN = 1 * MiB, WS_W1OUT = 12 * MiB, WS_WMIX = 18 * MiB, WS_WUPA = 29 * MiB, WS_WUPB = 30 * MiB, WS_WOUT = 31 * MiB;
constexpr size_t WS_W2IN = 33 * MiB, WS_W2OUT = 44 * MiB, WS_WG2 = 49 * MiB + 512 * 1024;
constexpr size_t WS_H = 50 * MiB, WS_F = 122 * MiB, WS_ACT = 194 * MiB, WS_U = 122 * MiB, WS_Y = 374 * MiB, WS_BON = 438 * MiB;
constexpr size_t WS_G = 440 * MiB, WS_O = 472 * MiB, WS_AG = 1 * MiB, WS_UG = 122 * MiB, WS_MG = 250 * MiB, WS_F2 = 50 * MiB, WS_H3 = 122 * MiB;
constexpr size_t WS_ACT2 = 194 * MiB, WS_END = 504 * MiB;
constexpr int LDS_BYTES = 163840;
constexpr size_t WS_BAR = 768 * 1024;
constexpr int LDS_BARST = 163072;

#ifndef PROBE_BITS
#define PROBE_BITS 0
#endif
struct Args { const float* in[29]; float* out; unsigned char* ws; int ph_lo, ph_hi; };

namespace pg8 {
constexpr int BM = 256, BK = 64, HALF = 128, HTB = HALF * BK * 2, NXCD = 8, WGM = 8;
DI int lds_byte(int r, int c) { const int st = (r >> 4) * 2 + (c >> 5), rr = r & 15, cc = c & 31, ob = rr * 64 + cc * 2; return st * 1024 + (ob ^ (((ob >> 9) & 1) << 5)); }
DI void stage_rc(int b, int& R, int& C) { const int st = b / 1024, sb = b % 1024, swz = sb ^ (((sb >> 9) & 1) << 5); R = (st >> 1) * 16 + swz / 64; C = (st & 1) * 32 + (swz % 64) / 2; }
DI int perm32(int rho) { const int n = rho >> 4, i = rho & 15; return 8 * (i >> 2) + 4 * n + (i & 3); }
struct Unit { int pm, pn; };
struct Gemm { const bf16_t* A; const bf16_t* Bt; int M, N, K; };
struct StaticOrder {
    int nM, nN, nwg, G, c;
    DI void init(int M, int N, int G_, int c_) { nM = M / BM; nN = N / BM; nwg = nM * nN; G = G_; c = c_; }
    DI bool next(int i, Unit& u) const {
        const long L = (long)i * G + c; if (L >= nwg) return false;
        int wgid = (int)L; { const int q = nwg / NXCD, r = nwg % NXCD, xcd = wgid % NXCD, off = wgid / NXCD; wgid = (xcd < r ? xcd * (q + 1) : r * (q + 1) + (xcd - r) * q) + off; }
        const int nig = WGM * nN, gid = wgid / nig, fm = gid * WGM, gsz = (nM - fm) < WGM ? (nM - fm) : WGM;
        u.pm = fm + ((wgid % nig) % gsz); u.pn = (wgid % nig) / gsz; return true;
    }
    DI void a_ready(const Unit&) const {}
    DI void done(const Unit&) const {}
};

template <int MODE> struct Epi {
    static constexpr bool PERM = true, AFTER_DRAIN = false;
    bf16_t* O; int ldc; const bf16_t* G; int ldg;
    DI void operator()(const f32x4 (&acc)[2][2][4][2], const Unit& u, int wr, int wc, int fr, int fq) const {
        const int row0 = u.pm * BM + wr * 64 + fr;
#pragma unroll
        for (int ai = 0; ai < 2; ++ai)
#pragma unroll
            for (int m = 0; m < 4; ++m) {
                const size_t row = (size_t)(row0 + ai * HALF + m * 16);
                if (MODE == 1) {
                    const int col = u.pn * 128 + wc * 32 + 8 * fq;
                    float v[8];
#pragma unroll
                    for (int n = 0; n < 2; ++n)
#pragma unroll
                        for (int j = 0; j < 4; ++j) { const float g = acc[ai][0][m][n][j], up = acc[ai][1][m][n][j]; v[4 * n + j] = (g * up) * __builtin_amdgcn_rcpf(1.f + __builtin_amdgcn_exp2f(g)); }
                    u32x4 w; w.x = pk2(v[0], v[1]); w.y = pk2(v[2], v[3]); w.z = pk2(v[4], v[5]); w.w = pk2(v[6], v[7]);
                    *(u32x4*)(O + row * ldc + col) = w;
                } else {
#pragma unroll
                    for (int bj = 0; bj < 2; ++bj) {
                        const int col = u.pn * BM + bj * HALF + wc * 32 + 8 * fq;
                        float v[8];
#pragma unroll
                        for (int n = 0; n < 2; ++n)
#pragma unroll
                            for (int j = 0; j < 4; ++j) v[4 * n + j] = acc[ai][bj][m][n][j];
                        if (MODE == 2) {
#pragma unroll
                            for (int j = 0; j < 8; ++j) v[j] = fast_sigmoid(v[j]);
                        }
                        if (MODE == 3 || MODE == 4) {
                            const u32x4 g = *(const u32x4*)(G + row * ldg + (MODE == 4 ? 1024 : 0) + col);
                            v[0] *= bflo(g.x); v[1] *= bfhi(g.x); v[2] *= bflo(g.y); v[3] *= bfhi(g.y); v[4] *= bflo(g.z); v[5] *= bfhi(g.z); v[6] *= bflo(g.w); v[7] *= bfhi(g.w);
                        }
                        if (MODE == 4) {
                            const u32x4 p = *(const u32x4*)(O + row * ldc + col);
                            v[0] += bflo(p.x); v[1] += bfhi(p.x); v[2] += bflo(p.y); v[3] += bfhi(p.y); v[4] += bflo(p.z); v[5] += bfhi(p.z); v[6] += bflo(p.w); v[7] += bfhi(p.w);
                        }
                        u32x4 w; w.x = pk2(v[0], v[1]); w.y = pk2(v[2], v[3]); w.z = pk2(v[4], v[5]); w.w = pk2(v[6], v[7]);
                        *(u32x4*)(O + row * ldc + col) = w;
                    }
                }
            }
    }
};

template <class EpiT, class Sched, bool ALIGN_EPI = false, bool SP2 = false>
DI void gemm_phase(LAS unsigned char* lds, const Gemm g, const Sched& S, const EpiT& E) {
    const int tid = threadIdx.x, wid = __builtin_amdgcn_readfirstlane(tid >> 6), lane = tid & 63, wr = wid >> 2, wc = wid & 3, fr = lane & 15, fq = lane >> 4;
    const int K = g.K, nt = K / BK;
    unsigned voffA[2], voffB[2];
#pragma unroll
    for (int i = 0; i < 2; ++i) { int R, C; stage_rc(tid * 16 + i * 8192, R, C); const int Rb = EpiT::PERM ? ((R & ~31) + perm32(R & 31)) : R;
        voffA[i] = (unsigned)(R * K + C) * 2u; voffB[i] = (unsigned)(Rb * K + C) * 2u; }
    const size_t kstep = (size_t)(BK * 2);
    const size_t hstep = (size_t)HALF * K * 2;
    const size_t tstep = 2 * hstep;
    const unsigned ldsw = (unsigned)wid * 1024u;
    const int aoff = lds_byte(wr * 64 + fr, fq * 8), boff = lds_byte(wc * 32 + fr, fq * 8);
#define PG8_SA(b, h) (((b) * 2 + (h)) * HTB)
#define PG8_SB(b, h) ((4 + (b) * 2 + (h)) * HTB)
#define PG8_STAGE(bufoff, gbase, voff) do { _Pragma("unroll") for (int _i = 0; _i < 2; ++_i) \
        __builtin_amdgcn_global_load_lds((const unsigned*)((const char*)(gbase) + (voff)[_i]), (LAS unsigned*)(lds + (bufoff) + ldsw + _i * 8192), 16, 0, 0); } while (0)
#define PG8_LDA(dst, b, h) do { _Pragma("unroll") for (int m = 0; m < 4; ++m) _Pragma("unroll") for (int k = 0; k < 2; ++k) dst[m][k] = *(const LAS bf16x8*)(lds + PG8_SA(b, h) + aoff + m * 2048 + k * 1024); } while (0)
#define PG8_LDB(dst, b, h) do { _Pragma("unroll") for (int n = 0; n < 2; ++n) _Pragma("unroll") for (int k = 0; k < 2; ++k) dst[n][k] = *(const LAS bf16x8*)(lds + PG8_SB(b, h) + boff + n * 2048 + k * 1024); } while (0)
#define PG8_MMA(ai, bj, At, Bt) do { __builtin_amdgcn_s_setprio(1); _Pragma("unroll") for (int m = 0; m < 4; ++m) _Pragma("unroll") for (int n = 0; n < 2; ++n) _Pragma("unroll") for (int k = 0; k < 2; ++k) \
        acc[ai][bj][m][n] = __builtin_amdgcn_mfma_f32_16x16x32_bf16(Bt[n][k], At[m][k], acc[ai][bj][m][n], 0, 0, 0); __builtin_amdgcn_s_setprio(0); } while (0)
#define PG8_WAIT_V(n) asm volatile("s_waitcnt vmcnt(" #n ")" ::: "memory")
#define PG8_WAIT_L(n) asm volatile("s_waitcnt lgkmcnt(" #n ")" ::: "memory")
#define PG8_BAR __builtin_amdgcn_s_barrier()
#define PG8_SCHED __builtin_amdgcn_sched_barrier(0)
    Unit cur, nxt; int ui = 0;
    if (!S.next(0, cur)) return;
    f32x4 acc[2][2][4][2];
#pragma unroll
    for (int a = 0; a < 2; ++a)
#pragma unroll
        for (int b = 0; b < 2; ++b)
#pragma unroll
            for (int m = 0; m < 4; ++m)
#pragma unroll
                for (int n = 0; n < 2; ++n) acc[a][b][m][n] = (f32x4){0.f, 0.f, 0.f, 0.f};
    bf16x8 At[4][2], B0[2][2], B1[2][2];
    const char* cA = (const char*)g.A + (size_t)cur.pm * tstep; const char* cB = (const char*)g.Bt + (size_t)cur.pn * tstep;
    S.a_ready(cur);
    if constexpr (SP2) {
        PG8_STAGE(PG8_SB(0, 0), cB, voffB); PG8_STAGE(PG8_SB(0, 1), cB + hstep, voffB); PG8_STAGE(PG8_SA(0, 0), cA, voffA); PG8_STAGE(PG8_SA(0, 1), cA + hstep, voffA);
        if (wr == 1) PG8_BAR;
        PG8_WAIT_V(2); PG8_BAR;
        PG8_STAGE(PG8_SB(1, 0), cB + kstep, voffB); PG8_STAGE(PG8_SA(1, 0), cA + kstep, voffA); PG8_STAGE(PG8_SB(1, 1), cB + hstep + kstep, voffB);
        PG8_WAIT_V(6); PG8_BAR;
    } else {
        PG8_STAGE(PG8_SB(0, 0), cB, voffB); PG8_STAGE(PG8_SA(0, 0), cA, voffA); PG8_STAGE(PG8_SB(0, 1), cB + hstep, voffB); PG8_STAGE(PG8_SA(0, 1), cA + hstep, voffA);
        if (wr == 1) PG8_BAR;
        PG8_WAIT_V(4); PG8_BAR;
        PG8_STAGE(PG8_SB(1, 0), cB + kstep, voffB); PG8_STAGE(PG8_SA(1, 0), cA + kstep, voffA); PG8_STAGE(PG8_SB(1, 1), cB + hstep + kstep, voffB);
        PG8_WAIT_V(6); PG8_BAR;
    }
    for (;;) {
        const bool has_next = S.next(ui + 1, nxt);
        const char* nA = has_next ? (const char*)g.A + (size_t)nxt.pm * tstep : cA; const char* nB = has_next ? (const char*)g.Bt + (size_t)nxt.pn * tstep : cB;
        for (int t = 0; t < nt; t += 2) {
            const bool last = (t == nt - 2);
            const char* a1 = cA + (size_t)(t + 1) * kstep;
            const char* a2 = last ? nA : cA + (size_t)(t + 2) * kstep; const char* b2 = last ? nB : cB + (size_t)(t + 2) * kstep;
            const char* a3 = a2 + kstep; const char* b3 = b2 + kstep;
            if (last && has_next) S.a_ready(nxt);
            if constexpr (SP2) {
            PG8_LDB(B0, 0, 0); PG8_LDB(B1, 0, 1); PG8_SCHED; PG8_LDA(At, 0, 0); PG8_STAGE(PG8_SA(1, 1), a1 + hstep, voffA);
            PG8_WAIT_V(8); PG8_WAIT_L(0); PG8_BAR; PG8_MMA(0, 0, At, B0); PG8_MMA(0, 1, At, B1); PG8_BAR; PG8_SCHED;
            PG8_LDA(At, 0, 1); PG8_STAGE(PG8_SB(0, 0), b2, voffB); PG8_STAGE(PG8_SB(0, 1), b2 + hstep, voffB); PG8_STAGE(PG8_SA(0, 0), a2, voffA);
            PG8_WAIT_V(8); PG8_WAIT_L(0); PG8_BAR; PG8_MMA(1, 0, At, B0); PG8_MMA(1, 1, At, B1); PG8_BAR; PG8_SCHED;
            PG8_LDB(B0, 1, 0); PG8_LDB(B1, 1, 1); PG8_SCHED; PG8_LDA(At, 1, 0); PG8_STAGE(PG8_SA(0, 1), a2 + hstep, voffA);
            PG8_WAIT_V(8); PG8_WAIT_L(0); PG8_BAR; PG8_MMA(0, 0, At, B0); PG8_MMA(0, 1, At, B1); PG8_BAR; PG8_SCHED;
            PG8_LDA(At, 1, 1); PG8_STAGE(PG8_SB(1, 0), b3, voffB); PG8_STAGE(PG8_SB(1, 1), b3 + hstep, voffB); PG8_STAGE(PG8_SA(1, 0), a3, voffA);
            PG8_WAIT_V(8); PG8_WAIT_L(0); PG8_BAR; PG8_MMA(1, 0, At, B0); PG8_MMA(1, 1, At, B1); PG8_BAR; PG8_SCHED;
            } else {
            PG8_LDB(B0, 0, 0); PG8_SCHED; PG8_LDA(At, 0, 0); PG8_STAGE(PG8_SA(1, 1), a1 + hstep, voffA);
            PG8_WAIT_L(8); PG8_BAR; PG8_WAIT_L(0); PG8_MMA(0, 0, At, B0); PG8_BAR; PG8_SCHED;
            PG8_LDB(B1, 0, 1); PG8_STAGE(PG8_SB(0, 0), b2, voffB);
            PG8_BAR; PG8_WAIT_L(0); PG8_MMA(0, 1, At, B1); PG8_BAR;
            PG8_LDA(At, 0, 1); PG8_STAGE(PG8_SA(0, 0), a2, voffA);
            PG8_BAR; PG8_WAIT_L(0); PG8_MMA(1, 0, At, B0); PG8_BAR; PG8_SCHED;
            PG8_STAGE(PG8_SB(0, 1), b2 + hstep, voffB);
            PG8_WAIT_V(6); PG8_BAR; PG8_MMA(1, 1, At, B1); PG8_BAR;
            PG8_LDB(B0, 1, 0); PG8_SCHED; PG8_LDA(At, 1, 0); PG8_STAGE(PG8_SA(0, 1), a2 + hstep, voffA);
            PG8_WAIT_L(8); PG8_BAR; PG8_WAIT_L(0); PG8_MMA(0, 0, At, B0); PG8_BAR; PG8_SCHED;
            PG8_LDB(B1, 1, 1); PG8_STAGE(PG8_SB(1, 0), b3, voffB);
            PG8_BAR; PG8_WAIT_L(0); PG8_MMA(0, 1, At, B1); PG8_BAR;
            PG8_LDA(At, 1, 1); PG8_STAGE(PG8_SA(1, 0), a3, voffA);
            PG8_BAR; PG8_WAIT_L(0); PG8_MMA(1, 0, At, B0); PG8_BAR; PG8_SCHED;
            PG8_STAGE(PG8_SB(1, 1), b3 + hstep, voffB);
            PG8_WAIT_V(6); PG8_BAR; PG8_MMA(1, 1, At, B1); PG8_BAR;
            }
        }
        if constexpr (ALIGN_EPI) { if (wr == 0) PG8_BAR; }
        if constexpr (!EpiT::AFTER_DRAIN) { E(acc, cur, wr, wc, fr, fq); S.done(cur); }
        if (!has_next) break;
#pragma unroll
        for (int a = 0; a < 2; ++a)
#pragma unroll
            for (int b = 0; b < 2; ++b)
#pragma unroll
                for (int m = 0; m < 4; ++m)
#pragma unroll
                    for (int n = 0; n < 2; ++n) acc[a][b][m][n] = (f32x4){0.f, 0.f, 0.f, 0.f};
        cur = nxt; cA = nA; cB = nB; ++ui;
        if constexpr (ALIGN_EPI) { if (wr == 1) PG8_BAR; }
    }
    PG8_WAIT_V(0);
    if constexpr (!ALIGN_EPI) { if (wr == 0) PG8_BAR; }
    PG8_BAR;
#undef PG8_SA
#undef PG8_SB
#undef PG8_STAGE
#undef PG8_LDA
#undef PG8_LDB
#undef PG8_MMA
#undef PG8_WAIT_V
#undef PG8_WAIT_L
#undef PG8_BAR
#undef PG8_SCHED
}
}

template <int MODE>
DI void run_gemm(LAS unsigned char* lds, const bf16_t* A, const bf16_t* Bt, int M, int N, int K, bf16_t* O, int ldc, const bf16_t* G, int ldg) {
    pg8::Gemm g{A, Bt, M, N, K}; pg8::StaticOrder S; S.init(M, N, (int)gridDim.x, (int)blockIdx.x);
    pg8::Epi<MODE> E{O, ldc, G, ldg};
    pg8::gemm_phase<pg8::Epi<MODE>, pg8::StaticOrder, true, true>(lds, g, S, E);
    __syncthreads();
}

DI int rowmap(int mode, int n) {
    if (mode == 1) { const int g = n >= DFF ? 1 : 0; const int j = n - g * DFF; return (j >> 7) * 256 + g * 128 + (j & 127); }
    if (mode == 2) return n < 1920 ? n : n + 128;
    return n;
}
DI void transpose_item(const float* W, int N, bf16_t* WT, int KP, int mode, LAS float* scr, int item, int lane) {
    const int nblk = N / 64, kb = item / nblk, nb = item % nblk, k0 = 64 * kb, n0 = 64 * nb;
    const float* src = W + (size_t)k0 * N + n0 + lane;
#pragma unroll 16
    for (int i = 0; i < 64; ++i) scr[i * 65 + lane] = src[(size_t)i * N];
    asm volatile("s_waitcnt lgkmcnt(0)" ::: "memory");
    const int c = lane & 7;
    const float wsc = mode == 1 ? (n0 < DFF ? -1.4426950408889634f : -0.6931471805599453f) : 1.f;
#pragma unroll
    for (int j = 0; j < 8; ++j) { const int n = (lane >> 3) + 8 * j; const LAS float* s = scr + (8 * c) * 65 + n;
        u32x4 o; o.x = pk2(s[0 * 65] * wsc, s[1 * 65] * wsc); o.y = pk2(s[2 * 65] * wsc, s[3 * 65] * wsc); o.z = pk2(s[4 * 65] * wsc, s[5 * 65] * wsc); o.w = pk2(s[6 * 65] * wsc, s[7 * 65] * wsc);
        *(u32x4*)(WT + (size_t)rowmap(mode, n0 + n) * KP + k0 + 8 * c) = o; }
    asm volatile("s_waitcnt lgkmcnt(0)" ::: "memory");
}

DI void p0_phase(const Args& a, LAS unsigned char* lds, int tid, int lane, int wave) {
    unsigned char* ws = a.ws;
    {
        const float* c = a.in[1]; const float* cctx = a.in[3]; const float* ada_w = a.in[4]; const float* ada_b = a.in[5];
        float* MOD = (float*)(ws + WS_MOD);
        LAS float* Sx = (LAS float*)lds;
        LAS float* RED = (LAS float*)(lds + 81920);
        for (int item = blockIdx.x; item < 144; item += gridDim.x) {
            for (int idx = tid; idx < 1024 * 20; idx += 512) { const int k = idx / 20, i = idx % 20; float v = 0.f;
                if (i < 16) v = c[i * 1024 + k]; else if (i == 16) v = cctx[k];
                Sx[idx] = v / (1.f + __expf(-v)); }
            __syncthreads();
            const int n0 = item * 64;
            float acc[17];
#pragma unroll
            for (int i = 0; i < 17; ++i) acc[i] = 0.f;
            for (int k = wave * 128; k < wave * 128 + 128; ++k) {
                const float wv = ada_w[(size_t)k * 9216 + n0 + lane];
                const LAS f32x4* sp = (const LAS f32x4*)(Sx + k * 20);
                const f32x4 s0 = sp[0], s1 = sp[1], s2 = sp[2], s3 = sp[3]; const float s16 = Sx[k * 20 + 16];
#pragma unroll
                for (int j = 0; j < 4; ++j) { acc[j] += s0[j] * wv; acc[4 + j] += s1[j] * wv; acc[8 + j] += s2[j] * wv; acc[12 + j] += s3[j] * wv; }
                acc[16] += s16 * wv;
            }
#pragma unroll
            for (int i = 0; i < 17; ++i) RED[(wave * 17 + i) * 64 + lane] = acc[i];
            __syncthreads();
            for (int idx = tid; idx < 17 * 64; idx += 512) { const int i = idx / 64, n = idx % 64; float s = 0.f;
#pragma unroll
                for (int w = 0; w < 8; ++w) s += RED[(w * 17 + i) * 64 + n];
                MOD[i * 9216 + n0 + n] = s + ada_b[n0 + n]; }
            __syncthreads();
        }
    }
    {
        LAS float* scr = (LAS float*)(lds + wave * 16640);
        const int gw = blockIdx.x * 8 + wave, NGW = gridDim.x * 8;
        constexpr int I1 = 16 * 88, I2 = 44 * 16, I3 = 16 * 86, I4 = 8 * 16, I6 = 16 * 16, I9 = 2 * 8;
        constexpr int NITEMS = I1 + I2 + I3 + I4 + I4 + I6 + I1 + I2 + I9;
        for (int it = gw; it < NITEMS; it += NGW) {
            int r = it;
            if (r < I1) { transpose_item(a.in[8], 2 * DFF, (bf16_t*)(ws + WS_W1IN), 1024, 1, scr, r, lane); continue; } r -= I1;
            if (r < I2) { transpose_item(a.in[9], 1024, (bf16_t*)(ws + WS_W1OUT), DFF, 0, scr, r, lane); continue; } r -= I2;
            if (r < I3) { transpose_item(a.in[10], 5504, (bf16_t*)(ws + WS_WMIX), 1024, 2, scr, r, lane); continue; } r -= I3;
            if (r < I4) { transpose_item(a.in[24], 1024, (bf16_t*)(ws + WS_WUPA), 512, 0, scr, r, lane); continue; } r -= I4;
            if (r < I4) { transpose_item(a.in[25], 1024, (bf16_t*)(ws + WS_WUPB), 512, 0, scr, r, lane); continue; } r -= I4;
            if (r < I6) { transpose_item(a.in[26], 1024, (bf16_t*)(ws + WS_WOUT), 1024, 0, scr, r, lane); continue; } r -= I6;
            if (r < I1) { transpose_item(a.in[27], 2 * DFF, (bf16_t*)(ws + WS_W2IN), 1024, 1, scr, r, lane); continue; } r -= I1;
            if (r < I2) { transpose_item(a.in[28], 1024, (bf16_t*)(ws + WS_W2OUT), DFF, 0, scr, r, lane); continue; } r -= I2;
            transpose_item(a.in[16], 512, (bf16_t*)(ws + WS_WG2), 256, 0, scr, r, lane);
        }
        const int gt = blockIdx.x * 512 + tid, NGT = gridDim.x * 512;
        const u32x4 z = {0u, 0u, 0u, 0u};
        for (int i = gt; i < 128 * 1024 / 8; i += NGT) *(u32x4*)(ws + WS_WMIX + (size_t)1920 * 1024 * 2 + (size_t)i * 16) = z;
        for (int i = gt; i < 512 * 16; i += NGT) { const int rr = i >> 4, cc = i & 15; *(u32x4*)(ws + WS_WG2 + (size_t)rr * 512 + 256 + cc * 16) = z; }
    }
}

template <bool HAS_F, bool WRITE_X, bool WRITE_H, bool XIN_BF = false, bool XOUT_BF = false>
DI void rowpass(const void* xin, const bf16_t* f, const float* postg, const float* gate, float alpha, void* xout,
                const float* preg, const float* shift, const float* scale, bf16_t* hout, int lane) {
    f32x4 v[4];
#pragma unroll
    for (int j = 0; j < 4; ++j) {
        if (XIN_BF) { const u32x2 raw = ((const u32x2*)xin)[lane + 64 * j]; v[j] = (f32x4){bflo(raw.x), bfhi(raw.x), bflo(raw.y), bfhi(raw.y)}; }
        else v[j] = ((const f32x4*)xin)[lane + 64 * j];
    }
    if (HAS_F) {
        f32x4 fv[4]; float s = 0.f;
#pragma unroll
        for (int j = 0; j < 4; ++j) { const u32x2 raw = ((const u32x2*)f)[lane + 64 * j]; fv[j] = (f32x4){bflo(raw.x), bfhi(raw.x), bflo(raw.y), bfhi(raw.y)};
            s += (fv[j].x * fv[j].x + fv[j].y * fv[j].y) + (fv[j].z * fv[j].z + fv[j].w * fv[j].w); }
        const float rs = alpha * rsqrtf(wave_sum(s) * (1.f / 1024.f) + EPS);
#pragma unroll
        for (int j = 0; j < 4; ++j) { const f32x4 pg = ((const f32x4*)postg)[lane + 64 * j], gt = ((const f32x4*)gate)[lane + 64 * j]; v[j] += rs * gt * fv[j] * pg; }
    }
    if (WRITE_X) {
#pragma unroll
        for (int j = 0; j < 4; ++j) {
            if (XOUT_BF) { u32x2 o; o.x = pk2(v[j].x, v[j].y); o.y = pk2(v[j].z, v[j].w); ((u32x2*)xout)[lane + 64 * j] = o; }
            else ((f32x4*)xout)[lane + 64 * j] = v[j];
        }
    }
    if (WRITE_H) {
        float s2 = 0.f;
#pragma unroll
        for (int j = 0; j < 4; ++j) s2 += (v[j].x * v[j].x + v[j].y * v[j].y) + (v[j].z * v[j].z + v[j].w * v[j].w);
        const float rstd = rsqrtf(wave_sum(s2) * (1.f / 1024.f) + EPS);
#pragma unroll
        for (int j = 0; j < 4; ++j) { const f32x4 g = ((const f32x4*)preg)[lane + 64 * j], sc = ((const f32x4*)scale)[lane + 64 * j], sh = ((const f32x4*)shift)[lane + 64 * j];
            const f32x4 hv = v[j] * rstd * g * (1.f + sc) + sh;
            u32x2 o; o.x = pk2(hv.x, hv.y); o.y = pk2(hv.z, hv.w);
            ((u32x2*)hout)[lane + 64 * j] = o; }
    }
}

template <bool HAS_F, bool WRITE_X, bool WRITE_H, bool XIN_BF, bool XOUT_BF>
DI void rowpass_block(int r0, int r1, const void* xin, const bf16_t* f, const float* postg, const float* MODv, int mod_fixed, int goff, float alpha, void* xout,
                      const float* preg, int shoff, int scoff, bf16_t* hout, int lane) {
    if (r0 >= r1) return;
    f32x4 Av[4], Bv[4], Cv[4];
    int curb = -2;
    f32x4 xr[4]; u32x2 xb[4], fr[4];
#define RB_LOAD(rr) do { _Pragma("unroll") for (int j = 0; j < 4; ++j) { \
        if (XIN_BF) xb[j] = ((const u32x2*)((const bf16_t*)xin + (size_t)(rr) * D))[lane + 64 * j]; else xr[j] = ((const f32x4*)((const float*)xin + (size_t)(rr) * D))[lane + 64 * j]; \
        if (HAS_F) fr[j] = ((const u32x2*)(f + (size_t)(rr) * D))[lane + 64 * j]; } } while (0)
    RB_LOAD(r0);
    for (int row = r0; row < r1; ++row) {
        const int bi = mod_fixed >= 0 ? mod_fixed : row / T;
        if (bi != curb) {
            curb = bi; const float* m = MODv + (size_t)bi * 9216;
#pragma unroll
            for (int j = 0; j < 4; ++j) {
                if (HAS_F) Av[j] = alpha * ((const f32x4*)(m + goff))[lane + 64 * j] * ((const f32x4*)postg)[lane + 64 * j];
                if (WRITE_H) { Bv[j] = ((const f32x4*)preg)[lane + 64 * j] * (1.f + ((const f32x4*)(m + scoff))[lane + 64 * j]); Cv[j] = ((const f32x4*)(m + shoff))[lane + 64 * j]; }
            }
        }
        f32x4 v[4], fv[4];
#pragma unroll
        for (int j = 0; j < 4; ++j) {
            if (XIN_BF) v[j] = (f32x4){bflo(xb[j].x), bfhi(xb[j].x), bflo(xb[j].y), bfhi(xb[j].y)}; else v[j] = xr[j];
            if (HAS_F) fv[j] = (f32x4){bflo(fr[j].x), bfhi(fr[j].x), bflo(fr[j].y), bfhi(fr[j].y)};
        }
        if (row + 1 < r1) RB_LOAD(row + 1);
        if (HAS_F) {
            float sq = 0.f;
#pragma unroll
            for (int j = 0; j < 4; ++j) sq += (fv[j].x * fv[j].x + fv[j].y * fv[j].y) + (fv[j].z * fv[j].z + fv[j].w * fv[j].w);
            const float rs = rsqrtf(wave_sum(sq) * (1.f / 1024.f) + EPS);
#pragma unroll
            for (int j = 0; j < 4; ++j) v[j] += rs * Av[j] * fv[j];
        }
        if (WRITE_X) {
#pragma unroll
            for (int j = 0; j < 4; ++j) {
                if (XOUT_BF) { u32x2 o; o.x = pk2(v[j].x, v[j].y); o.y = pk2(v[j].z, v[j].w); ((u32x2*)((bf16_t*)xout + (size_t)row * D))[lane + 64 * j] = o; }
                else ((f32x4*)((float*)xout + (size_t)row * D))[lane + 64 * j] = v[j];
            }
        }
        if (WRITE_H) {
            float s2 = 0.f;
#pragma unroll
            for (int j = 0; j < 4; ++j) s2 += (v[j].x * v[j].x + v[j].y * v[j].y) + (v[j].z * v[j].z + v[j].w * v[j].w);
            const float rstd = rsqrtf(wave_sum(s2) * (1.f / 1024.f) + EPS);
#pragma unroll
            for (int j = 0; j < 4; ++j) { const f32x4 hv = v[j] * rstd * Bv[j] + Cv[j]; u32x2 o; o.x = pk2(hv.x, hv.y); o.y = pk2(hv.z, hv.w); ((u32x2*)(hout + (size_t)row * D))[lane + 64 * j] = o; }
        }
    }
#undef RB_LOAD
}
DI void wave_rows(int n, int w, int nw, int& r0, int& r1) { const int per = (n + nw - 1) / nw; r0 = w * per; r1 = r0 + per < n ? r0 + per : n; }

DI void prep_phase(const Args& a, int lane, int wave) {
    bf16_t* U = (bf16_t*)(a.ws + WS_U); bf16_t* AG = (bf16_t*)(a.ws + WS_AG);
    const float* shw = a.in[11];
    const int gw = blockIdx.x * 8 + wave, NGW = gridDim.x * 8;
    for (int row = gw; row < ML; row += NGW) {
        const int t = row & (T - 1);
        bf16_t* ur = U + (size_t)row * UP;
        u32x2 o = {0u, 0u};
        if (lane < 32) {
            const int col = 1792 + 4 * lane;
            const u32x2 cu = *(const u32x2*)(ur + col);
            u32x2 pv = {0u, 0u}, nx = {0u, 0u};
            if (t > 0) pv = *(const u32x2*)(ur - UP + col);
            if (t < T - 1) nx = *(const u32x2*)(ur + UP + col);
            const f32x4 w0 = *(const f32x4*)(shw + col), w1 = *(const f32x4*)(shw + 1920 + col), w2 = *(const f32x4*)(shw + 3840 + col);
            const float v0 = bflo(pv.x) * w0.x + bflo(cu.x) * w1.x + bflo(nx.x) * w2.x;
            const float v1 = bfhi(pv.x) * w0.y + bfhi(cu.x) * w1.y + bfhi(nx.x) * w2.y;
            const float v2 = bflo(pv.y) * w0.z + bflo(cu.y) * w1.z + bflo(nx.y) * w2.z;
            const float v3 = bfhi(pv.y) * w0.w + bfhi(cu.y) * w1.w + bfhi(nx.y) * w2.w;
            o.x = pk2(fast_sigmoid(v0), fast_sigmoid(v1)); o.y = pk2(fast_sigmoid(v2), fast_sigmoid(v3));
        }
        *(u32x2*)(AG + (size_t)row * 256 + 4 * lane) = o;
        {
            const int vec = lane >> 2, pi = lane & 3;
            bf16_t* base = ur + (vec < 8 ? 2048 + vec * 64 : 2560 + (vec - 8) * 64) + (pi >> 1) * 32 + (pi & 1) * 8;
            const float pos = (float)((pi >> 1) ? (t & 63) : (t >> 6));
            const u32x4 z1 = *(const u32x4*)base, z2 = *(const u32x4*)(base + 16);
            float a1[8] = {bflo(z1.x), bfhi(z1.x), bflo(z1.y), bfhi(z1.y), bflo(z1.z), bfhi(z1.z), bflo(z1.w), bfhi(z1.w)};
            float a2[8] = {bflo(z2.x), bfhi(z2.x), bflo(z2.y), bfhi(z2.y), bflo(z2.z), bfhi(z2.z), bflo(z2.w), bfhi(z2.w)};
            float o1[8], o2[8];
#pragma unroll
            for (int j = 0; j < 8; ++j) {
                const float fi = (float)((pi & 1) * 8 + j);
                const float fr = __builtin_amdgcn_exp2f(-0.8304820237218406f * fi);
                float rev = pos * fr * 0.15915494309189535f; rev -= floorf(rev);
                const float sn = __builtin_amdgcn_sinf(rev), cs = __builtin_amdgcn_cosf(rev);
                o1[j] = a1[j] * cs - a2[j] * sn; o2[j] = a2[j] * cs + a1[j] * sn;
            }
            u32x4 w1, w2;
            w1.x = pk2(o1[0], o1[1]); w1.y = pk2(o1[2], o1[3]); w1.z = pk2(o1[4], o1[5]); w1.w = pk2(o1[6], o1[7]);
            w2.x = pk2(o2[0], o2[1]); w2.y = pk2(o2[2], o2[3]); w2.z = pk2(o2[4], o2[5]); w2.w = pk2(o2[6], o2[7]);
            *(u32x4*)base = w1; *(u32x4*)(base + 16) = w2;
        }
    }
}

constexpr int SC_W = 0, SC_KK = 8192, SC_BB = 16384, SC_KD = 24576, SC_R = 32768, SC_V = 40960, SC_KC = 49152, SC_TW = 57344, SC_TA = 57344 + 4608,
              SC_YS = 66560, SC_BON = 74752, SC_SHW = 75008, SC_RAW = 78848, SC_A = SC_RAW  ,
              SC_SF = 100608  , SC_SV = 116992  ,
              SC_SUB = 130304, SUB_BYTES = 15616  , SB_KRT = 0  , SB_BDT = 4608  ,
              SB_BH = 9216  , SB_MBK = 14336  , SB_G16 = 15360  ,
              SC_MM = SC_KC  , MM_BYTES = 3840, MM_MB1 = 0  , MM_MB2 = 1280  , MM_MBT = 2560  ;
static_assert(SC_SUB + 2 * SUB_BYTES <= 163072 && 2 * MM_BYTES <= 8192, "scan LDS map");
DI float sum16(float x) {
    x += dpp_f(x, 0); x += dpp_f(x, 1); x += dpp_f(x, 2);
    x += __builtin_bit_cast(float, __builtin_amdgcn_update_dpp(0, __builtin_bit_cast(int, x), 0x140, 0xF, 0xF, true));
    return x;
}
DI void scan_chunk_pos(int ch, int dir, int b, int& seg, int& c0, int& L, size_t& segrow) {
    if (ch < 8) { seg = 0; c0 = (dir ? 7 - ch : ch) * 32; } else { seg = 1; c0 = (dir ? 63 - (ch - 8) : ch - 8) * 32; }
    L = seg ? T : CT; segrow = seg ? (size_t)b * T : (size_t)ML + (size_t)b * CT;
}
DI void scan_issue_raw(const bf16_t* U, LAS unsigned char* lds, int chx, int dir, int b, int wave, const int (&pre)[3]) {
    int seg, c0, L; size_t segrow; scan_chunk_pos(chx, dir, b, seg, c0, L, segrow);
#pragma unroll
    for (int it = 0; it < 3; ++it) {
        if (pre[it] >= 0) {
            int p = c0 - 1 + (pre[it] & 255); p = p < 0 ? 0 : (p > L - 1 ? L - 1 : p);
            const bf16_t* gp = U + (segrow + p) * UP + (pre[it] >> 8);
            __builtin_amdgcn_global_load_lds((const unsigned*)gp, (LAS unsigned*)(lds + SC_RAW + (wave + 8 * it) * 1024), 16, 0, 0);
        }
    }
}
DI void scanA_item(LAS unsigned char* lds, int i, int chn, int c0, int L) {
                const int grp = chn >> 3, c8 = (chn & 7) * 8;
                const int p = c0 + i;
                const LAS unsigned char* rp = lds + SC_RAW + (i * 40 + chn) * 16;
                u32x4 pv = *(const LAS u32x4*)rp; const u32x4 cu = *(const LAS u32x4*)(rp + 640); u32x4 nx = *(const LAS u32x4*)(rp + 1280);
                if (p == 0) pv = (u32x4){0u, 0u, 0u, 0u};
                if (p == L - 1) nx = (u32x4){0u, 0u, 0u, 0u};
                const LAS float* sw = (const LAS float*)(lds + SC_SHW) + chn * 8;
                const f32x4 w0a = *(const LAS f32x4*)sw, w0b = *(const LAS f32x4*)(sw + 4);
                const f32x4 w1a = *(const LAS f32x4*)(sw + 320), w1b = *(const LAS f32x4*)(sw + 324);
                const f32x4 w2a = *(const LAS f32x4*)(sw + 640), w2b = *(const LAS f32x4*)(sw + 644);
                f32x4 va, vb;
                va.x = bflo(pv.x) * w0a.x + bflo(cu.x) * w1a.x + bflo(nx.x) * w2a.x;
                va.y = bfhi(pv.x) * w0a.y + bfhi(cu.x) * w1a.y + bfhi(nx.x) * w2a.y;
                va.z = bflo(pv.y) * w0a.z + bflo(cu.y) * w1a.z + bflo(nx.y) * w2a.z;
                va.w = bfhi(pv.y) * w0a.w + bfhi(cu.y) * w1a.w + bfhi(nx.y) * w2a.w;
                vb.x = bflo(pv.z) * w0b.x + bflo(cu.z) * w1b.x + bflo(nx.z) * w2b.x;
                vb.y = bfhi(pv.z) * w0b.y + bfhi(cu.z) * w1b.y + bfhi(nx.z) * w2b.y;
                vb.z = bflo(pv.w) * w0b.z + bflo(cu.w) * w1b.z + bflo(nx.w) * w2b.z;
                vb.w = bfhi(pv.w) * w0b.w + bfhi(cu.w) * w1b.w + bfhi(nx.w) * w2b.w;
                if (grp < 3) {
                    LAS float* dst = (LAS float*)(lds + (grp == 0 ? SC_R : (grp == 1 ? SC_KC : SC_V))) + i * 64 + c8;
                    *(LAS f32x4*)dst = va; *(LAS f32x4*)(dst + 4) = vb;
                } else {
                    if (grp == 3) {
#pragma unroll
                        for (int j = 0; j < 4; ++j) { va[j] = 1.f - 2.f * __builtin_amdgcn_rcpf(__builtin_amdgcn_exp2f(2.885390081777927f * va[j]) + 1.f);
                                                      vb[j] = 1.f - 2.f * __builtin_amdgcn_rcpf(__builtin_amdgcn_exp2f(2.885390081777927f * vb[j]) + 1.f); }
                    }
                    u32x4 w; w.x = pk2(va.x, va.y); w.y = pk2(va.z, va.w); w.z = pk2(vb.x, vb.y); w.w = pk2(vb.z, vb.w);
                    *(LAS u32x4*)(lds + (grp == 3 ? SC_TW : SC_TA) + (i * 72 + c8) * 2) = w;
                }
}
DI void scan_phase(const Args& a, LAS unsigned char* lds, int tid, int lane, int wave) {
    const bf16_t* U = (const bf16_t*)(a.ws + WS_U); bf16_t* Y = (bf16_t*)(a.ws + WS_Y); float* BON = (float*)(a.ws + WS_BON);
    const float* shw = a.in[11]; const float* w0p = a.in[12]; const float* w2p = a.in[13]; const float* a0p = a.in[14]; const float* a2p = a.in[15];
    const float* k_k = a.in[17]; const float* k_a = a.in[18]; const float* r_k = a.in[19];
    const int hh = lane >> 5, r32 = lane & 31;
    for (int item = blockIdx.x; item < 256; item += gridDim.x) {
        const int b = item >> 4, h = (item >> 1) & 7, dir = item & 1;
        int pre[3];
#pragma unroll
        for (int it = 0; it < 3; ++it) {
            const int j = wave + 8 * it, q = 64 * j + lane;
            if (j < 22 && q < 1360) { const int ts = q / 40, chn = q % 40, grp = chn >> 3, c8 = (chn & 7) * 8;
                pre[it] = ts | (((grp < 3 ? grp * 512 + h * 64 : (grp == 3 ? 1536 : 1664) + dir * 64) + c8) << 8); }
            else pre[it] = -1;
        }
        scan_issue_raw(U, lds, 0, dir, b, wave, pre);
        bf16x8 bfr[4];
        float bias0 = 0.f;
        {
            const int mat = wave & 1, nb = (wave >> 1) & 1;
            const float* Wl = (mat == 0 ? w2p : a2p) + (size_t)dir * 64 * 512 + h * 64;
#pragma unroll
            for (int ks = 0; ks < 4; ++ks) {
                float t8[8];
#pragma unroll
                for (int j = 0; j < 8; ++j) t8[j] = Wl[(size_t)(16 * ks + 8 * hh + j) * 512 + 32 * nb + r32];
                u32x4 w; w.x = pk2(t8[0], t8[1]); w.y = pk2(t8[2], t8[3]); w.z = pk2(t8[4], t8[5]); w.w = pk2(t8[6], t8[7]);
                bfr[ks] = __builtin_bit_cast(bf16x8, w);
            }
            bias0 = ((mat == 0 ? w0p : a0p) + dir * 512 + h * 64)[32 * nb + r32];
        }
        const int ci = tid >> 4, cq = tid & 15, ck4 = 4 * cq;
        const f32x4 kk4 = *(const f32x4*)(k_k + h * 64 + ck4), ka4 = *(const f32x4*)(k_a + h * 64 + ck4), rk4 = *(const f32x4*)(r_k + h * 64 + ck4);
        for (int idx = tid; idx < 960; idx += 512) { const int tap = idx / 320, cc = idx % 320, grp = cc >> 6;
            const int col = (grp < 3 ? grp * 512 + h * 64 : (grp == 3 ? 1536 : 1664) + dir * 64) + (cc & 63);
            *(LAS float*)(lds + SC_SHW + idx * 4) = shw[tap * 1920 + col]; }
        for (int idx = tid; idx < 4096; idx += 512) *(LAS float*)(lds + SC_SF + idx * 4) = 0.f;
        for (int idx = tid; idx < 13312 / 16; idx += 512) *(LAS u32x4*)(lds + SC_SV + idx * 16) = (u32x4){0u, 0u, 0u, 0u};
        asm volatile("s_waitcnt vmcnt(0)" ::: "memory");
        __syncthreads();
        for (int ch = 0; ch < 72; ++ch) {
            int seg, c0, L; size_t segrow; scan_chunk_pos(ch, dir, b, seg, c0, L, segrow);
#pragma unroll 1
            for (int item2 = tid; item2 < (ch == 0 ? 1280 : 768); item2 += 512) {
                int i, chn;
                if (item2 < 768) { i = item2 / 24; chn = item2 - 24 * i; } else { const int j = (item2 - 768) & 255; i = j >> 3; chn = (item2 < 1024 ? 24 : 32) + (j & 7); }
                scanA_item(lds, i, chn, c0, L);
            }
            __syncthreads();
            {
                const int mat = wave & 1, nb = (wave >> 1) & 1, half = wave >> 2;
                const LAS unsigned char* X = lds + (mat == 0 ? SC_TW : SC_TA);
                f32x16 acc0;
#pragma unroll
                for (int i = 0; i < 16; ++i) acc0[i] = 0.f;
#pragma unroll
                for (int ks = 0; ks < 4; ++ks) {
                    const bf16x8 af = *(const LAS bf16x8*)(X + (r32 * 72 + 16 * ks + 8 * hh) * 2);
                    acc0 = __builtin_amdgcn_mfma_f32_32x32x16_bf16(af, bfr[ks], acc0, 0, 0, 0);
                }
                LAS float* dst = (LAS float*)(lds + (mat == 0 ? SC_W : SC_A)) + 32 * nb + r32;
#pragma unroll
                for (int i8 = 0; i8 < 8; ++i8) {
                    const float av = half ? acc0[8 + i8] : acc0[i8];
                    float s0 = fast_sigmoid(av + bias0);
                    if (mat == 0) s0 = __builtin_amdgcn_exp2f(-0.8750612633917001f * s0);
                    dst[(crow(i8, hh) + 16 * half) * 64] = s0;
                }
            }
            __syncthreads();
            {
                const f32x4 kc = *(const LAS f32x4*)(lds + SC_KC + (ci * 64 + ck4) * 4);
                const f32x4 kkr = kc * kk4;
                float ss = (kkr.x * kkr.x + kkr.y * kkr.y) + (kkr.z * kkr.z + kkr.w * kkr.w);
                ss = sum16(ss);
                const f32x4 kk = kkr * rsqrtf(ss + 1e-12f);
                const f32x4 av = *(const LAS f32x4*)(lds + SC_A + (ci * 64 + ck4) * 4);
                const f32x4 bb = kk * av;
                const f32x4 kd = kc * (1.f + (av - 1.f) * ka4);
                const f32x4 rv = *(const LAS f32x4*)(lds + SC_R + (ci * 64 + ck4) * 4);
                const f32x4 pb = rv * kd * rk4;
                const float bon = sum16((pb.x + pb.y) + (pb.z + pb.w));
                *(LAS f32x4*)(lds + SC_KK + (ci * 64 + ck4) * 4) = kk;
                *(LAS f32x4*)(lds + SC_BB + (ci * 64 + ck4) * 4) = bb;
                *(LAS f32x4*)(lds + SC_KD + (ci * 64 + ck4) * 4) = kd;
                if (cq == 0) *(LAS float*)(lds + SC_BON + ci * 4) = bon;
            }
            __syncthreads();
            if (ch + 1 < 72) scan_issue_raw(U, lds, ch + 1, dir, b, wave, pre);
            {
                int tido = tid; asm volatile("" : "+v"(tido));
                const int ln = tido & 63, l15 = tido & 15, g4 = (tido >> 4) & 3;
                {
                    const int sub = wave >> 2, th = wave & 3, k = ln;
                    LAS unsigned char* sb = lds + SC_SUB + sub * SUB_BYTES;
                    float pg[17]; pg[0] = 1.f;
#pragma unroll
                    for (int st = 0; st < 16; ++st) {
                        const int tok = dir ? 31 - (16 * sub + st) : 16 * sub + st;
                        pg[st + 1] = pg[st] * *(const LAS float*)(lds + SC_W + (tok * 64 + k) * 4);
                    }
                    const float g = pg[16];
                    if (th == 0) *(LAS float*)(sb + SB_G16 + k * 4) = g;
#define SC_D_STEP(TT) do { const int t = (TT); const float gp = pg[TT], gc = pg[(TT) + 1]; \
                        const int tok = dir ? 31 - (16 * sub + t) : 16 * sub + t; \
                        const float kkv = *(const LAS float*)(lds + SC_KK + (tok * 64 + k) * 4), bbv = *(const LAS float*)(lds + SC_BB + (tok * 64 + k) * 4); \
                        const float kdv = *(const LAS float*)(lds + SC_KD + (tok * 64 + k) * 4), rv = *(const LAS float*)(lds + SC_R + (tok * 64 + k) * 4); \
                        const float ig = __builtin_amdgcn_rcpf(gc), bt = bbv * ig, dt = kdv * ig; \
                        *(LAS bf16_t*)(sb + SB_KRT + (t * 72 + k) * 2) = (bf16_t)(pk2(kkv * gp, 0.f) & 0xffffu); \
                        *(LAS bf16_t*)(sb + SB_KRT + ((16 + t) * 72 + k) * 2) = (bf16_t)(pk2(rv * gc, 0.f) & 0xffffu); \
                        *(LAS bf16_t*)(sb + SB_BDT + (t * 72 + k) * 2) = (bf16_t)(pk2(bt, 0.f) & 0xffffu); \
                        *(LAS bf16_t*)(sb + SB_BDT + ((16 + t) * 72 + k) * 2) = (bf16_t)(pk2(dt, 0.f) & 0xffffu); \
                        *(LAS bf16_t*)(sb + SB_BH + (k * 40 + 8 * (t >> 2) + (t & 3)) * 2) = (bf16_t)(pk2(bt * g, 0.f) & 0xffffu);         \
                        *(LAS bf16_t*)(sb + SB_BH + (k * 40 + 8 * (t >> 2) + 4 + (t & 3)) * 2) = (bf16_t)(pk2(dt * g, 0.f) & 0xffffu);     } while (0)
                    if (th == 0) { SC_D_STEP(0); SC_D_STEP(1); SC_D_STEP(2); SC_D_STEP(3); }
                    else if (th == 1) { SC_D_STEP(4); SC_D_STEP(5); SC_D_STEP(6); SC_D_STEP(7); }
                    else if (th == 2) { SC_D_STEP(8); SC_D_STEP(9); SC_D_STEP(10); SC_D_STEP(11); }
                    else { SC_D_STEP(12); SC_D_STEP(13); SC_D_STEP(14); SC_D_STEP(15); }
#undef SC_D_STEP
                }
                __syncthreads();
                {
                    const int sub = wave >> 2, wq = wave & 3, jb = wq >> 1, tb = wq & 1;
                    const LAS unsigned char* sb = lds + SC_SUB + sub * SUB_BYTES; LAS unsigned char* mm = lds + SC_MM + sub * MM_BYTES;
                    f32x4 acc = {0.f, 0.f, 0.f, 0.f};
#pragma unroll
                    for (int kb = 0; kb < 2; ++kb) {
                        const bf16x8 av = *(const LAS bf16x8*)(sb + SB_BDT + ((16 * jb + l15) * 72 + 32 * kb + 8 * g4) * 2);
                        const bf16x8 bv = *(const LAS bf16x8*)(sb + SB_KRT + ((16 * tb + l15) * 72 + 32 * kb + 8 * g4) * 2);
                        acc = __builtin_amdgcn_mfma_f32_16x16x32_bf16(av, bv, acc, 0, 0, 0);
                    }
                    const int t = l15;
#pragma unroll
                    for (int r = 0; r < 4; ++r) {
                        const int j = 4 * g4 + r;
                        const float mv = (tb == 0 ? (j < t) : (j <= t)) ? acc[r] : 0.f;
                        if (wq == 0) *(LAS float*)((LAS unsigned char*)sb + SB_MBK + (j * 16 + t) * 4) = mv;
                        else if (wq == 2) { *(LAS bf16_t*)(mm + MM_MB1 + (t * 40 + j) * 2) = (bf16_t)(pk2(mv, 0.f) & 0xffffu); *(LAS bf16_t*)(mm + MM_MB1 + (t * 40 + 16 + j) * 2) = 0; }
                        else if (wq == 1) *(LAS bf16_t*)(mm + MM_MB2 + (t * 40 + 8 * g4 + r) * 2) = (bf16_t)(pk2(mv, 0.f) & 0xffffu);
                        else *(LAS bf16_t*)(mm + MM_MB2 + (t * 40 + 8 * g4 + 4 + r) * 2) = (bf16_t)(pk2(mv, 0.f) & 0xffffu);
                    }
                }
                if ((wave & 3) == 0) {
                    const int sub = wave >> 2;
                    const LAS unsigned char* sb = lds + SC_SUB + sub * SUB_BYTES; LAS unsigned char* mm = lds + SC_MM + sub * MM_BYTES;
                    float acc[16];
#pragma unroll
                    for (int u = 0; u < 16; ++u) acc[u] = 0.f;
#pragma unroll
                    for (int t = 0; t < 16; ++t) {
                        const float sv = ((l15 == t) ? 1.f : 0.f) - acc[t];
                        if (ln < 16) { *(LAS bf16_t*)(mm + MM_MBT + (t * 40 + 8 * (ln >> 2) + (ln & 3)) * 2) = (bf16_t)(pk2(sv, 0.f) & 0xffffu);
                                       *(LAS bf16_t*)(mm + MM_MBT + (t * 40 + 8 * (ln >> 2) + 4 + (ln & 3)) * 2) = 0; }
#pragma unroll
                        for (int uq = 0; uq < 4; ++uq) {
                            if (4 * uq + 3 > t) {
                                const f32x4 m4 = *(const LAS f32x4*)(sb + SB_MBK + (t * 16 + 4 * uq) * 4);
#pragma unroll
                                for (int uu = 0; uu < 4; ++uu) if (4 * uq + uu > t) acc[4 * uq + uu] += sv * m4[uu];
                            }
                        }
                    }
                }
                asm volatile("s_waitcnt vmcnt(0)" ::: "memory");
                __syncthreads();
                if (wave >= 4) {
                    if (ch + 1 < 72) {
                        int segn, c0n, Ln; size_t segrown; scan_chunk_pos(ch + 1, dir, b, segn, c0n, Ln, segrown);
                        const int j = tid - 256;
                        scanA_item(lds, j >> 3, 24 + (j & 7), c0n, Ln);
                        scanA_item(lds, j >> 3, 32 + (j & 7), c0n, Ln);
                    }
                } else {
                    const int v = 16 * wave + l15;
                    const LAS unsigned char* svrow = lds + SC_SV + v * 208;
#pragma unroll 1
                    for (int sub = 0; sub < 2; ++sub) {
                        const LAS unsigned char* sb = lds + SC_SUB + sub * SUB_BYTES; const LAS unsigned char* mm = lds + SC_MM + sub * MM_BYTES;
                        u32x2 vc;
                        {
                            float vv[4];
#pragma unroll
                            for (int r = 0; r < 4; ++r) { const int tok = dir ? 31 - (16 * sub + 4 * g4 + r) : 16 * sub + 4 * g4 + r; vv[r] = *(const LAS float*)(lds + SC_V + (tok * 64 + v) * 4); }
                            vc.x = pk2(vv[0], vv[1]); vc.y = pk2(vv[2], vv[3]);
                            *(LAS u32x2*)((LAS unsigned char*)svrow + 128 + 8 * g4) = vc;
                        }
                        f32x4 acc = {0.f, 0.f, 0.f, 0.f};
#pragma unroll
                        for (int kb = 0; kb < 2; ++kb)
                            acc = __builtin_amdgcn_mfma_f32_16x16x32_bf16(*(const LAS bf16x8*)(sb + SB_KRT + (l15 * 72 + 32 * kb + 8 * g4) * 2), *(const LAS bf16x8*)(svrow + 64 * kb + 16 * g4), acc, 0, 0, 0);
                        acc = __builtin_amdgcn_mfma_f32_16x16x32_bf16(*(const LAS bf16x8*)(mm + MM_MB1 + (l15 * 40 + 8 * g4) * 2), *(const LAS bf16x8*)(svrow + 128 + 16 * g4), acc, 0, 0, 0);
                        u32x4 rb; rb.x = pk2(acc[0], acc[1]); rb.y = pk2(acc[2], acc[3]); rb.z = 0u; rb.w = 0u;
                        const f32x4 sa = __builtin_amdgcn_mfma_f32_16x16x32_bf16(*(const LAS bf16x8*)(mm + MM_MBT + (l15 * 40 + 8 * g4) * 2), __builtin_bit_cast(bf16x8, rb), (f32x4){0.f, 0.f, 0.f, 0.f}, 0, 0, 0);
                        u32x4 sb4; sb4.x = pk2(-sa[0], -sa[1]); sb4.y = pk2(-sa[2], -sa[3]); sb4.z = vc.x; sb4.w = vc.y;
                        const bf16x8 bop = __builtin_bit_cast(bf16x8, sb4);
                        f32x4 ya = {0.f, 0.f, 0.f, 0.f};
#pragma unroll
                        for (int kb = 0; kb < 2; ++kb)
                            ya = __builtin_amdgcn_mfma_f32_16x16x32_bf16(*(const LAS bf16x8*)(sb + SB_KRT + ((16 + l15) * 72 + 32 * kb + 8 * g4) * 2), *(const LAS bf16x8*)(svrow + 64 * kb + 16 * g4), ya, 0, 0, 0);
                        ya = __builtin_amdgcn_mfma_f32_16x16x32_bf16(*(const LAS bf16x8*)(mm + MM_MB2 + (l15 * 40 + 8 * g4) * 2), bop, ya, 0, 0, 0);
#pragma unroll
                        for (int r = 0; r < 4; ++r) { const int tok = dir ? 31 - (16 * sub + 4 * g4 + r) : 16 * sub + 4 * g4 + r; *(LAS float*)(lds + SC_YS + (tok * 64 + v) * 4) = ya[r]; }
#pragma unroll
                        for (int kt = 0; kt < 4; ++kt) {
                            const f32x4 dS = __builtin_amdgcn_mfma_f32_16x16x32_bf16(*(const LAS bf16x8*)(sb + SB_BH + ((16 * kt + l15) * 40 + 8 * g4) * 2), bop, (f32x4){0.f, 0.f, 0.f, 0.f}, 0, 0, 0);
                            const int k = 16 * kt + 4 * g4;
                            const f32x4 g16 = *(const LAS f32x4*)(sb + SB_G16 + k * 4);
                            const f32x4 sn = *(const LAS f32x4*)(lds + SC_SF + (v * 64 + k) * 4) * g16 + dS;
                            *(LAS f32x4*)(lds + SC_SF + (v * 64 + k) * 4) = sn;
                            u32x2 w; w.x = pk2(sn[0], sn[1]); w.y = pk2(sn[2], sn[3]);
                            *(LAS u32x2*)((LAS unsigned char*)svrow + k * 2) = w;
                        }
                    }
                }
            }
            asm volatile("s_waitcnt vmcnt(0)" ::: "memory");
            __syncthreads();
            if (seg) {
                const f32x4 yv = *(const LAS f32x4*)(lds + SC_YS + (ci * 64 + ck4) * 4);
                u32x2 o; o.x = pk2(yv.x, yv.y); o.y = pk2(yv.z, yv.w);
                *(u32x2*)(Y + ((size_t)dir * ML + (size_t)b * T + c0 + ci) * 512 + h * 64 + ck4) = o;
                if (tid < 32) BON[((size_t)dir * ML + (size_t)b * T + c0 + tid) * 8 + h] = *(const LAS float*)(lds + SC_BON + tid * 4);
            }
        }
        __syncthreads();
    }
}

DI s16x4 tr_read(const LAS unsigned char* p) { return __builtin_bit_cast(s16x4, __builtin_amdgcn_ds_read_tr16_b64_v4i16((LAS v4i16_t*)p)); }
DI void attn_phase(const Args& a, LAS unsigned char* lds, int tid, int lane, int wave) {
    const bf16_t* U = (const bf16_t*)(a.ws + WS_U); bf16_t* O = (bf16_t*)(a.ws + WS_O);
    const float* dl = a.in[22]; const float* subg = a.in[23];
    const float lam = __expf(wave_sum(dl[lane] * dl[64 + lane])) - __expf(wave_sum(dl[128 + lane] * dl[192 + lane])) + 0.2f;
    const int c = wave & 1, qblk = wave >> 1, hh = lane >> 5, r32 = lane & 31;
    constexpr int KP = 272, VP = 320, KBYTES = 64 * KP, STG = KBYTES + 64 * VP;
    constexpr float SCL = 0.125f * 1.4426950408889634f;
    const int i16 = lane & 15, q_ = i16 >> 2, p_ = i16 & 3, g_ = lane >> 4;
    for (int u0 = blockIdx.x; u0 < 1024; u0 += gridDim.x) {
        int u = u0;
        if (gridDim.x == 256) { const int j = u0 & 255, i = u0 >> 8; u = (j & 7) * 128 + i * 32 + (j >> 3); }
        const int b = u >> 6, h = (u >> 4) & 3, qb = u & 15;
        const size_t qrow = (size_t)b * T + qb * 128 + qblk * 32 + r32;
        bf16x8 qf[4];
#pragma unroll
        for (int ks = 0; ks < 4; ++ks) qf[ks] = *(const bf16x8*)(U + qrow * UP + 2048 + h * 128 + c * 64 + 16 * ks + 8 * hh);
        f32x16 o[4];
#pragma unroll
        for (int eb = 0; eb < 4; ++eb)
#pragma unroll
            for (int i = 0; i < 16; ++i) o[eb][i] = 0.f;
        float m_used = -1e30f, l = 0.f;
        const int skey0 = tid >> 4, sch = tid & 15;
        u32x4 rk0, rk1, rv0, rv1;
        const bf16_t* kp = U + ((size_t)ML + (size_t)b * CT + skey0) * UP + h * 128 + sch * 8;
        const bf16_t* const kp_lat = U + ((size_t)b * T + skey0) * UP + h * 128 + sch * 8;
#define ATT_LOAD(tt) do { \
            rk0 = *(const u32x4*)(kp + 2560); rv0 = *(const u32x4*)(kp + 3072); \
            rk1 = *(const u32x4*)(kp + 32 * UP + 2560); rv1 = *(const u32x4*)(kp + 32 * UP + 3072); \
            kp = ((tt) == 3) ? kp_lat : kp + 64 * UP; } while (0)
#define ATT_STORE(buf) do { \
            LAS unsigned char* kb_ = lds + (buf) * STG; LAS unsigned char* vb_ = kb_ + KBYTES; \
            *(LAS u32x4*)(kb_ + skey0 * KP + sch * 16) = rk0; *(LAS u32x4*)(kb_ + (skey0 + 32) * KP + sch * 16) = rk1; \
            *(LAS u32x4*)(vb_ + skey0 * VP + sch * 16) = rv0; *(LAS u32x4*)(vb_ + (skey0 + 32) * VP + sch * 16) = rv1; } while (0)
        ATT_LOAD(0); ATT_STORE(0);
        __syncthreads();
        for (int t = 0; t < 36; ++t) {
            if (t + 1 < 36) ATT_LOAD(t + 1);
            const LAS unsigned char* Kt = lds + (t & 1) * STG; const LAS unsigned char* Vt = Kt + KBYTES;
            f32x16 s0, s1;
#pragma unroll
            for (int i = 0; i < 16; ++i) { s0[i] = 0.f; s1[i] = 0.f; }
            __builtin_amdgcn_s_setprio(1);
#pragma unroll
            for (int ks = 0; ks < 4; ++ks) {
                const bf16x8 k0 = *(const LAS bf16x8*)(Kt + r32 * KP + (c * 64 + 16 * ks + 8 * hh) * 2);
                const bf16x8 k1 = *(const LAS bf16x8*)(Kt + (32 + r32) * KP + (c * 64 + 16 * ks + 8 * hh) * 2);
                s0 = __builtin_amdgcn_mfma_f32_32x32x16_bf16(k0, qf[ks], s0, 0, 0, 0);
                s1 = __builtin_amdgcn_mfma_f32_32x32x16_bf16(k1, qf[ks], s1, 0, 0, 0);
            }
            __builtin_amdgcn_s_setprio(0);
            float tmax = fmaxf(s0[0], s1[0]), tmax2 = fmaxf(s0[1], s1[1]);
#pragma unroll
            for (int i = 2; i < 16; i += 2) { tmax = max3_s(tmax, s0[i], s1[i]); tmax2 = max3_s(tmax2, s0[i + 1], s1[i + 1]); }
            tmax = fmaxf(tmax, tmax2);
            tmax = fmaxf(tmax, __shfl_xor(tmax, 32));
            const float tm = tmax * SCL;
            if (__any(tm > m_used + 8.f)) {
                const float mn = fmaxf(m_used, tm);
                const float al = __builtin_amdgcn_exp2f(m_used - mn);
#pragma unroll
                for (int eb = 0; eb < 4; ++eb) o[eb] = o[eb] * al;
                l *= al; m_used = mn;
            }
            bf16x8 pf[2][2];
            {
                float p0[16], p1[16];
#pragma unroll
                for (int i = 0; i < 16; ++i) { p0[i] = __builtin_amdgcn_exp2f(__builtin_fmaf(s0[i], SCL, -m_used)); p1[i] = __builtin_amdgcn_exp2f(__builtin_fmaf(s1[i], SCL, -m_used)); l += p0[i] + p1[i]; }
#pragma unroll
                for (int s = 0; s < 2; ++s) {
                    u32x4 w0, w1;
                    w0.x = pk2(p0[8 * s + 0], p0[8 * s + 1]); w0.y = pk2(p0[8 * s + 2], p0[8 * s + 3]); w0.z = pk2(p0[8 * s + 4], p0[8 * s + 5]); w0.w = pk2(p0[8 * s + 6], p0[8 * s + 7]);
                    w1.x = pk2(p1[8 * s + 0], p1[8 * s + 1]); w1.y = pk2(p1[8 * s + 2], p1[8 * s + 3]); w1.z = pk2(p1[8 * s + 4], p1[8 * s + 5]); w1.w = pk2(p1[8 * s + 6], p1[8 * s + 7]);
                    pf[0][s] = __builtin_bit_cast(bf16x8, w0); pf[1][s] = __builtin_bit_cast(bf16x8, w1);
                }
            }
            __builtin_amdgcn_s_setprio(1);
#pragma unroll
            for (int kb = 0; kb < 2; ++kb)
#pragma unroll
                for (int s = 0; s < 2; ++s)
#pragma unroll
                    for (int eb = 0; eb < 4; ++eb) {
                        const LAS unsigned char* vb = Vt + (32 * kb + 16 * s + 4 * hh + q_) * VP + (32 * eb + 16 * (g_ & 1) + 4 * p_) * 2;
                        const s16x4 lo = tr_read(vb), hi = tr_read(vb + 8 * VP);
                        const bf16x8 vf = {lo[0], lo[1], lo[2], lo[3], hi[0], hi[1], hi[2], hi[3]};
                        o[eb] = __builtin_amdgcn_mfma_f32_32x32x16_bf16(vf, pf[kb][s], o[eb], 0, 0, 0);
                    }
            __builtin_amdgcn_s_setprio(0);
            if (t + 1 < 36) ATT_STORE((t + 1) & 1);
            __syncthreads();
        }
#undef ATT_LOAD
#undef ATT_STORE
        l += __shfl_xor(l, 32);
        const float inv = 1.f / l;
        LAS float* XO = (LAS float*)lds + qblk * 4096;
        if (c == 1) {
            const float sc = inv * lam;
#pragma unroll
            for (int eb = 0; eb < 4; ++eb)
#pragma unroll
                for (int i = 0; i < 16; ++i) XO[(32 * eb + crow(i, hh)) * 32 + r32] = o[eb][i] * sc;
        }
        __syncthreads();
        if (c == 0) {
            float ss = 0.f;
#pragma unroll
            for (int eb = 0; eb < 4; ++eb)
#pragma unroll
                for (int i = 0; i < 16; ++i) { const float vv = o[eb][i] * inv - XO[(32 * eb + crow(i, hh)) * 32 + r32]; o[eb][i] = vv; ss += vv * vv; }
            ss += __shfl_xor(ss, 32);
            const float rstd = rsqrtf(ss * (1.f / 128.f) + EPS) * 0.8f;
#pragma unroll
            for (int eb = 0; eb < 4; ++eb)
#pragma unroll
                for (int g4 = 0; g4 < 4; ++g4) {
                    const int e0 = 32 * eb + 8 * g4 + 4 * hh;
                    const f32x4 sg = *(const f32x4*)(subg + e0);
                    u32x2 w; w.x = pk2(o[eb][4 * g4 + 0] * rstd * sg.x, o[eb][4 * g4 + 1] * rstd * sg.y); w.y = pk2(o[eb][4 * g4 + 2] * rstd * sg.z, o[eb][4 * g4 + 3] * rstd * sg.w);
                    *(u32x2*)(O + qrow * 512 + h * 128 + e0) = w;
                }
        }
        __syncthreads();
    }
}

DI void readout_phase(const Args& a, int lane, int wave) {
    const bf16_t* U = (const bf16_t*)(a.ws + WS_U); bf16_t* Y = (bf16_t*)(a.ws + WS_Y); const float* BON = (const float*)(a.ws + WS_BON); const bf16_t* Gb = (const bf16_t*)(a.ws + WS_G);
    const float* shw = a.in[11]; const float* lng = a.in[20]; const float* lnb = a.in[21];
    const int gw = blockIdx.x * 8 + wave, NGW = gridDim.x * 8;
    const int c8 = 8 * lane, head = lane >> 3;
    int r0, r1; wave_rows(ML, gw, NGW, r0, r1);
    if (r0 >= r1) return;
    const float* sw = shw + 1024 + c8;
    const f32x4 w0a = *(const f32x4*)sw, w0b = *(const f32x4*)(sw + 4), w1a = *(const f32x4*)(sw + 1920), w1b = *(const f32x4*)(sw + 1924), w2a = *(const f32x4*)(sw + 3840), w2b = *(const f32x4*)(sw + 3844);
    const f32x4 lga = *(const f32x4*)(lng + c8), lgb = *(const f32x4*)(lng + c8 + 4), lba = *(const f32x4*)(lnb + c8), lbb = *(const f32x4*)(lnb + c8 + 4);
    const float lg[8] = {lga.x, lga.y, lga.z, lga.w, lgb.x, lgb.y, lgb.z, lgb.w}, lb[8] = {lba.x, lba.y, lba.z, lba.w, lbb.x, lbb.y, lbb.z, lbb.w};
    const u32x4 z4 = {0u, 0u, 0u, 0u};
    const bf16_t* ub = U + 1024 + c8;
    u32x4 pv = (r0 > 0) ? *(const u32x4*)(ub + (size_t)(r0 - 1) * UP) : z4;
    u32x4 cu = *(const u32x4*)(ub + (size_t)r0 * UP);
    u32x4 nx = (r0 + 1 < ML) ? *(const u32x4*)(ub + (size_t)(r0 + 1) * UP) : z4;
    u32x4 yf = *(const u32x4*)(Y + (size_t)r0 * 512 + c8), yb = *(const u32x4*)(Y + ((size_t)ML + r0) * 512 + c8), gr = *(const u32x4*)(Gb + (size_t)r0 * 512 + c8);
    float bonus = BON[(size_t)r0 * 8 + head] + BON[((size_t)ML + r0) * 8 + head];
    for (int row = r0; row < r1; ++row) {
        u32x4 nyf = z4, nyb = z4, ngr = z4, nnx = z4; float nbonus = 0.f;
        if (row + 1 < r1) {
            const int rn = row + 1;
            nyf = *(const u32x4*)(Y + (size_t)rn * 512 + c8); nyb = *(const u32x4*)(Y + ((size_t)ML + rn) * 512 + c8); ngr = *(const u32x4*)(Gb + (size_t)rn * 512 + c8);
            nbonus = BON[(size_t)rn * 8 + head] + BON[((size_t)ML + rn) * 8 + head];
            if (rn + 1 < ML) nnx = *(const u32x4*)(ub + (size_t)(rn + 1) * UP);
        }
        float y[8] = {bflo(yf.x) + bflo(yb.x), bfhi(yf.x) + bfhi(yb.x), bflo(yf.y) + bflo(yb.y), bfhi(yf.y) + bfhi(yb.y),
                      bflo(yf.z) + bflo(yb.z), bfhi(yf.z) + bfhi(yb.z), bflo(yf.w) + bflo(yb.w), bfhi(yf.w) + bfhi(yb.w)};
        float sm = 0.f;
#pragma unroll
        for (int j = 0; j < 8; ++j) sm += y[j];
        const float mu = sum8(sm) * (1.f / 64.f);
        float q = 0.f;
#pragma unroll
        for (int j = 0; j < 8; ++j) { y[j] -= mu; q += y[j] * y[j]; }
        const float rstd = rsqrtf(sum8(q) * (1.f / 64.f) + 64e-5f);
        const bool first = (row & (T - 1)) == 0, last = (row & (T - 1)) == T - 1;
        const u32x4 pvv = first ? z4 : pv, nxv = last ? z4 : nx;
        float vc[8];
        vc[0] = bflo(pvv.x) * w0a.x + bflo(cu.x) * w1a.x + bflo(nxv.x) * w2a.x;
        vc[1] = bfhi(pvv.x) * w0a.y + bfhi(cu.x) * w1a.y + bfhi(nxv.x) * w2a.y;
        vc[2] = bflo(pvv.y) * w0a.z + bflo(cu.y) * w1a.z + bflo(nxv.y) * w2a.z;
        vc[3] = bfhi(pvv.y) * w0a.w + bfhi(cu.y) * w1a.w + bfhi(nxv.y) * w2a.w;
        vc[4] = bflo(pvv.z) * w0b.x + bflo(cu.z) * w1b.x + bflo(nxv.z) * w2b.x;
        vc[5] = bfhi(pvv.z) * w0b.y + bfhi(cu.z) * w1b.y + bfhi(nxv.z) * w2b.y;
        vc[6] = bflo(pvv.w) * w0b.z + bflo(cu.w) * w1b.z + bflo(nxv.w) * w2b.z;
        vc[7] = bfhi(pvv.w) * w0b.w + bfhi(cu.w) * w1b.w + bfhi(nxv.w) * w2b.w;
        const float gv[8] = {bflo(gr.x), bfhi(gr.x), bflo(gr.y), bfhi(gr.y), bflo(gr.z), bfhi(gr.z), bflo(gr.w), bfhi(gr.w)};
        float ov[8];
#pragma unroll
        for (int j = 0; j < 8; ++j) ov[j] = (y[j] * rstd * lg[j] + lb[j] + bonus * vc[j]) * gv[j];
        u32x4 w; w.x = pk2(ov[0], ov[1]); w.y = pk2(ov[2], ov[3]); w.z = pk2(ov[4], ov[5]); w.w = pk2(ov[6], ov[7]);
        *(u32x4*)(Y + (size_t)row * 512 + c8) = w;
        pv = cu; cu = nx; nx = nnx; yf = nyf; yb = nyb; gr = ngr; bonus = nbonus;
    }
}

#define XB_TMO      128
#define XB_XCNT(j)  (256  + 64 * (j))
#define XB_XSUB(j)  (1280 + 64 * (j))
#define XB_XGEN(j)  (2304 + 64 * (j))
#define XB_TOP      3328
#define XB_TOPGEN   3392
#define XCD_BAR_WORDS 3456
#define XB_SPIN_CAP (1u << 18)

__device__ __forceinline__ unsigned xb_ld(unsigned* p)              { return __hip_atomic_load(p, __ATOMIC_RELAXED, __HIP_MEMORY_SCOPE_AGENT); }
__device__ __forceinline__ unsigned xb_add(unsigned* p, unsigned v) { return __hip_atomic_fetch_add(p, v, __ATOMIC_RELAXED, __HIP_MEMORY_SCOPE_AGENT); }
__device__ __forceinline__ unsigned xb_xcc_id() { return (unsigned)__builtin_amdgcn_s_getreg((3 << 11) | 20) & 0xFu; }
#define XB_SPIN(cond, bar) do { unsigned _sp = 0; while (cond) { __builtin_amdgcn_s_sleep(1); \
    if ((++_sp & 255u) == 0u) { if (xb_ld(&(bar)[XB_TMO])) break; if (_sp > XB_SPIN_CAP) { atomicAdd(&(bar)[XB_TMO], 1u); break; } } } } while (0)

struct XcdBarrier {
    unsigned* bar; unsigned x;
    volatile LAS unsigned* st;
};

__device__ __forceinline__ XcdBarrier xcd_barrier_post(unsigned* bar, volatile LAS unsigned* st) {
    XcdBarrier b; b.bar = bar; b.x = xb_xcc_id(); b.st = st;
    if (threadIdx.x == 0) (void)xb_add(&bar[XB_XCNT(b.x)], 1u);
    return b;
}
__device__ __forceinline__ void xcd_barrier_complete(unsigned* bar, unsigned x, unsigned& nloc, unsigned& nx) {
    const unsigned G = gridDim.x * gridDim.y * gridDim.z;
    unsigned sum, cnt, mine, sp = 0u;
    for (;;) {
        sum = 0u; cnt = 0u; mine = 0u;
#pragma unroll
        for (unsigned j = 0; j < 16; ++j) { const unsigned c = xb_ld(&bar[XB_XCNT(j)]); sum += c; cnt += (c > 0u) ? 1u : 0u; mine = (j == x) ? c : mine; }
        if (sum == G) break;
        __builtin_amdgcn_s_sleep(1);
        if ((++sp & 255u) == 0u) { if (xb_ld(&bar[XB_TMO])) break; if (sp > XB_SPIN_CAP) { atomicAdd(&bar[XB_TMO], 1u); break; } }
    }
    nloc = mine > 0u ? mine : 1u; nx = cnt > 0u ? cnt : 1u;
}

__device__ __forceinline__ void xcd_barrier(const XcdBarrier& b) {
    asm volatile("s_waitcnt vmcnt(0)" ::: "memory");
    __syncthreads();
    if (threadIdx.x == 0) {
        unsigned* bar = b.bar;
        __builtin_amdgcn_s_waitcnt(0);
        unsigned nloc = b.st[0], nx = b.st[1];
        if (nloc == 0u) { xcd_barrier_complete(bar, b.x, nloc, nx); b.st[0] = nloc; b.st[1] = nx; }
        const unsigned old = xb_add(&bar[XB_XSUB(b.x)], 1u);
        const unsigned gen = old / nloc;
        if (old + 1u == (gen + 1u) * nloc) {
            __builtin_amdgcn_fence(__ATOMIC_RELEASE, "agent");
            asm volatile("s_waitcnt vmcnt(0)" ::: "memory");
            const unsigned og = xb_add(&bar[XB_TOP], 1u);
            const unsigned tg = og / nx;
            if (og + 1u == (tg + 1u) * nx) xb_add(&bar[XB_TOPGEN], 1u);
            else XB_SPIN(xb_ld(&bar[XB_TOPGEN]) == tg, bar);
            __builtin_amdgcn_fence(__ATOMIC_ACQUIRE, "agent");
            xb_add(&bar[XB_XGEN(b.x)], 1u);
            asm volatile("s_waitcnt vmcnt(0)" ::: "memory");
        } else {
            XB_SPIN(xb_ld(&bar[XB_XGEN(b.x)]) == gen, bar);
            __builtin_amdgcn_fence(__ATOMIC_ACQUIRE, "agent");
            asm volatile("s_waitcnt vmcnt(0)" ::: "memory");
        }
    }
    __syncthreads();
}

__global__ void __launch_bounds__(512, 2) mk_fwd(Args a) {
    extern __shared__ __attribute__((aligned(16))) unsigned char lds_raw[];
    cg::grid_group grid = cg::this_grid();
    LAS unsigned char* lds = (LAS unsigned char*)lds_raw;
    const int tid = threadIdx.x, lane = tid & 63, wave = __builtin_amdgcn_readfirstlane(tid >> 6);
    unsigned char* ws = a.ws;
    const int gw = blockIdx.x * 8 + wave, NGW = gridDim.x * 8;
    const float* MOD = (const float*)(ws + WS_MOD);
    const float* preg = a.in[6]; const float* postg = a.in[7];
    bf16_t* H = (bf16_t*)(ws + WS_H);
    const int lo = a.ph_lo & 0xff, hi = a.ph_hi;
    if (tid < 2) *(volatile LAS unsigned*)(lds + LDS_BARST + 4 * tid) = 0u;
    __syncthreads();
    const XcdBarrier xbar = xcd_barrier_post((unsigned*)(ws + WS_BAR), (volatile LAS unsigned*)(lds + LDS_BARST));
#define IN(k) (lo <= (k) && (k) < hi)
#define SEAM(k) do { if (IN(k) && IN((k) + 1)) xcd_barrier(xbar); } while (0)
    if (hi > 4096) grid.sync();

#ifndef NO_P0
    if (IN(0)) p0_phase(a, lds, tid, lane, wave);
#endif
    SEAM(0);
#pragma unroll 1
    for (int rsy = 0; rsy < ((a.ph_lo >> 16) & 63); ++rsy) xcd_barrier(xbar);
    if (IN(1)) {
        int r0, r1;
        wave_rows(ML, gw, NGW, r0, r1);
        rowpass_block<false, false, true, false, false>(r0, r1, a.in[0], nullptr, nullptr, MOD, -1, 0, 0.f, nullptr, preg, 0, 1024, H, lane);
        wave_rows(MC, gw, NGW, r0, r1);
        rowpass_block<false, false, true, false, false>(r0, r1, a.in[2], nullptr, nullptr, MOD, 16, 0, 0.f, nullptr, preg, 0, 1024, H + (size_t)ML * D, lane);
    }
    SEAM(1);
    if (IN(2)) run_gemm<1>(lds, H, (const bf16_t*)(ws + WS_W1IN), MA, 2 * DFF, D, (bf16_t*)(ws + WS_ACT), DFF, nullptr, 0);
    SEAM(2);
    bf16_t* const X1 = (bf16_t*)a.out;
    bf16_t* const X2 = (bf16_t*)(ws + WS_Y);
    const bool split3 = gridDim.x > 64;
    if (IN(3)) {
        const bf16_t* F = (const bf16_t*)(ws + WS_F);
        run_gemm<0>(lds, (const bf16_t*)(ws + WS_ACT), (const bf16_t*)(ws + WS_W1OUT), ML, D, DFF, (bf16_t*)(ws + WS_F), D, nullptr, 0);
        xcd_barrier(xbar);
        run_gemm<0>(lds, (const bf16_t*)(ws + WS_ACT) + (size_t)ML * DFF, (const bf16_t*)(ws + WS_W1OUT), MC, D, DFF, (bf16_t*)(ws + WS_F) + (size_t)ML * D, D, nullptr, 0);
        if (split3 && blockIdx.x >= 64) {
            const int gw3 = ((int)blockIdx.x - 64) * 8 + wave, NGW3 = ((int)gridDim.x - 64) * 8;
            int r0, r1; wave_rows(ML, gw3, NGW3, r0, r1);
            rowpass_block<true, true, true, false, true>(r0, r1, a.in[0], F, postg, MOD, -1, 2048, 0.5f, X1, preg + 1024, 3072, 4096, H, lane);
        }
    }
    SEAM(3);
    if (IN(4)) {
        const bf16_t* F = (const bf16_t*)(ws + WS_F);
        int r0, r1;
        if (!split3) { wave_rows(ML, gw, NGW, r0, r1); rowpass_block<true, true, true, false, true>(r0, r1, a.in[0], F, postg, MOD, -1, 2048, 0.5f, X1, preg + 1024, 3072, 4096, H, lane); }
        wave_rows(MC, gw, NGW, r0, r1);
        rowpass_block<true, false, true, false, false>(r0, r1, a.in[2], F + (size_t)ML * D, postg, MOD, 16, 2048, 0.5f, nullptr, preg + 1024, 3072, 4096, H + (size_t)ML * D, lane);
    }
    SEAM(4);
    if (IN(5)) run_gemm<0>(lds, H, (const bf16_t*)(ws + WS_WMIX), MA, UP, D, (bf16_t*)(ws + WS_U), UP, nullptr, 0);
    SEAM(5);
#ifndef NO_PREP
    if (IN(6)) prep_phase(a, lane, wave);
#endif
    SEAM(6);
    if (IN(7)) {
#ifndef NO_SCAN
#pragma unroll 1
        for (int rep = 0; rep <= ((a.ph_lo >> 8) & 3); ++rep) scan_phase(a, lds, tid, lane, wave);
#endif
#ifndef NO_ATTN
#pragma unroll 1
        for (int rep = 0; rep <= ((a.ph_lo >> 10) & 3); ++rep) attn_phase(a, lds, tid, lane, wave);
#endif
        run_gemm<0>(lds, (const bf16_t*)(ws + WS_AG), (const bf16_t*)(ws + WS_WG2), ML, 512, 256, (bf16_t*)(ws + WS_G), 512, nullptr, 0);
    }
    SEAM(7);
#ifndef NO_READ
    if (IN(8)) readout_phase(a, lane, wave);
#endif
    SEAM(8);
    if (IN(9)) run_gemm<2>(lds, H, (const bf16_t*)(ws + WS_WMIX) + (size_t)UP * D, ML, 2048, D, (bf16_t*)(ws + WS_UG), 2048, nullptr, 0);
    SEAM(9);
    if (IN(10)) {
        run_gemm<3>(lds, (const bf16_t*)(ws + WS_Y), (const bf16_t*)(ws + WS_WUPA), ML, D, 512, (bf16_t*)(ws + WS_MG), D, (const bf16_t*)(ws + WS_UG), 2048);
        run_gemm<4>(lds, (const bf16_t*)(ws + WS_O), (const bf16_t*)(ws + WS_WUPB), ML, D, 512, (bf16_t*)(ws + WS_MG), D, (const bf16_t*)(ws + WS_UG), 2048);
    }
    SEAM(10);
    if (IN(11)) run_gemm<0>(lds, (const bf16_t*)(ws + WS_MG), (const bf16_t*)(ws + WS_WOUT), ML, D, D, (bf16_t*)(ws + WS_F2), D, nullptr, 0);
    SEAM(11);
    if (IN(12)) {
        const bf16_t* F = (const bf16_t*)(ws + WS_F2); bf16_t* H3 = (bf16_t*)(ws + WS_H3);
        int r0, r1; wave_rows(ML, gw, NGW, r0, r1);
        rowpass_block<true, true, true, true, true>(r0, r1, X1, F, postg + 1024, MOD, -1, 5120, 1.0f, X2, preg + 2048, 6144, 7168, H3, lane);
    }
    SEAM(12);
    if (IN(13)) run_gemm<1>(lds, (const bf16_t*)(ws + WS_H3), (const bf16_t*)(ws + WS_W2IN), ML, 2 * DFF, D, (bf16_t*)(ws + WS_ACT2), DFF, nullptr, 0);
    SEAM(13);
    if (IN(14)) run_gemm<0>(lds, (const bf16_t*)(ws + WS_ACT2), (const bf16_t*)(ws + WS_W2OUT), ML, D, DFF, (bf16_t*)(ws + WS_F2), D, nullptr, 0);
    SEAM(14);
    if (IN(15)) {
        const bf16_t* F = (const bf16_t*)(ws + WS_F2);
        int r0, r1; wave_rows(ML, gw, NGW, r0, r1);
        rowpass_block<true, true, false, true, false>(r0, r1, X2, F, postg + 2048, MOD, -1, 8192, 0.5f, a.out, nullptr, 0, 0, nullptr, lane);
    }
}

extern "C" void kernel_launch(void* const* d_in, const int* in_sizes, int n_in, void* d_out, int out_size, void* d_ws, size_t ws_size, hipStream_t stream) {
    static int grid = 0;
    if (grid == 0) {
        if (n_in != 29 || ws_size < WS_END) { fprintf(stderr, "kernel_launch: unexpected n_in %d / ws %zu\n", n_in, ws_size); grid = -1; return; }
        int dev = 0, cus = 0, per_cu = 0;
        hipGetDevice(&dev);
        hipDeviceGetAttribute(&cus, hipDeviceAttributeMultiprocessorCount, dev);
        hipFuncSetAttribute((const void*)mk_fwd, hipFuncAttributeMaxDynamicSharedMemorySize, LDS_BYTES);
        hipOccupancyMaxActiveBlocksPerMultiprocessor(&per_cu, (const void*)mk_fwd, 512, LDS_BYTES);
        (void)hipGetLastError();
        if (per_cu < 1) { fprintf(stderr, "kernel_launch: occupancy query says %d blocks per CU\n", per_cu); per_cu = 1; }
        grid = cus;
    }
    if (grid < 0) return;
    if (hipMemsetAsync((char*)d_ws + WS_BAR, 0, 16384, stream) != hipSuccess) { fprintf(stderr, "kernel_launch: memset of barrier words failed\n"); return; }
    Args a{};
    for (int i = 0; i < 29; ++i) a.in[i] = (const float*)d_in[i];
    a.out = (float*)d_out; a.ws = (unsigned char*)d_ws; a.ph_lo = PROBE_BITS; a.ph_hi = 16;
    void* args[] = {&a};
    hipError_t e = hipLaunchCooperativeKernel((const void*)mk_fwd, dim3(grid), dim3(512), args, LDS_BYTES, stream);
    if (e != hipSuccess) fprintf(stderr, "cooperative launch failed: %s (grid %d)\n", hipGetErrorString(e), grid);
}
```
